# Optimizing an MI355X kernel written in HIP

```python
import jax
import jax.numpy as jnp
from jax import lax
import numpy as np

D_MODEL = 2048
BATCH = 2
SEQ = 8192
DEPTH = 2

LRU_WIDTH = D_MODEL // 2
LRU_HEADS = 4
LRU_BLOCK = LRU_WIDTH // LRU_HEADS
CONV_WIDTH = 4
LRU_C = 8.0
HGRN_WIDTH = D_MODEL // 2
HGRN_EXPAND = 128
HGRN_HEADS = HGRN_WIDTH // HGRN_EXPAND
HGRN_HEAD_V = HGRN_WIDTH // HGRN_HEADS
HGRN_CHUNK = 64
ATTN_HEADS = 16
HEAD_DIM = D_MODEL // ATTN_HEADS
ROPE_DIM = HEAD_DIM // 4
ROPE_THETA = 500000.0
DILATED_GROUPS = ((128, 1), (512, 4), (2048, 16))
DSWA_BLOCK = 128
D_FF = 4 * D_MODEL
NORM_EPS = 1e-6
N_EVEN = (DEPTH + 1) // 2
N_ODD = DEPTH // 2
IN_SPLITS = (LRU_WIDTH, 2 * LRU_WIDTH, 2 * LRU_WIDTH + HGRN_WIDTH,
             2 * LRU_WIDTH + 2 * HGRN_WIDTH, 2 * LRU_WIDTH + 3 * HGRN_WIDTH)
IN_COLS = 2 * LRU_WIDTH + 4 * HGRN_WIDTH

kernel_name = 'hybrid_rglru_hgrn2_dilated_swa'

F32 = jnp.float32


def rms_norm(x, gain):
    xf = x.astype(F32)
    y = xf * lax.rsqrt(jnp.mean(xf * xf, axis=-1, keepdims=True) + NORM_EPS)
    return (y * gain.astype(F32)).astype(x.dtype)


def causal_depthwise_conv(x, w, b):
    out = lax.conv_general_dilated(
        x, w[:, None, :].astype(x.dtype), window_strides=(1,),
        padding=[(CONV_WIDTH - 1, 0)], dimension_numbers=('NWC', 'WIO', 'NWC'),
        feature_group_count=x.shape[-1])
    return out + b.astype(x.dtype)


def rg_lru(xb, w_a, b_a, w_i, b_i, lam):
    bsz, seq, _ = xb.shape
    xf = xb.astype(F32)
    xh = xf.reshape(bsz, seq, LRU_HEADS, LRU_BLOCK)
    r = jax.nn.sigmoid(jnp.einsum('bshi,hij->bshj', xh, w_a.astype(F32)).reshape(bsz, seq, LRU_WIDTH)
                       + b_a.astype(F32))
    i = jax.nn.sigmoid(jnp.einsum('bshi,hij->bshj', xh, w_i.astype(F32)).reshape(bsz, seq, LRU_WIDTH)
                       + b_i.astype(F32))
    log_a = -LRU_C * r * jax.nn.softplus(-lam.astype(F32))
    a = jnp.exp(log_a)
    u = jnp.sqrt(-jnp.expm1(2.0 * log_a)) * (i * xf)

    def combine(left, right):
        a_l, h_l = left
        a_r, h_r = right
        return a_l * a_r, a_r * h_l + h_r

    _, h = lax.associative_scan(combine, (a, u), axis=1)
    return h


def hgrn2(q_raw, f_raw, v_raw, g_raw, lower_bound, g_norm):
    bsz, seq, _ = q_raw.shape
    n_chunks = seq // HGRN_CHUNK
    q = jax.nn.silu(q_raw.astype(F32))
    fz = f_raw.astype(F32)
    log_f = jnp.log(lower_bound + (1.0 - lower_bound) * jax.nn.sigmoid(fz))
    k = (1.0 - lower_bound) * jax.nn.sigmoid(-fz)

    def to_chunks(t, d):
        return t.reshape(bsz, n_chunks, HGRN_CHUNK, HGRN_HEADS, d).transpose(1, 0, 3, 2, 4)

    xs = (to_chunks(q, HGRN_EXPAND), to_chunks(k, HGRN_EXPAND),
          to_chunks(log_f, HGRN_EXPAND), to_chunks(v_raw.astype(F32), HGRN_HEAD_V))
    causal = jnp.tril(jnp.ones((HGRN_CHUNK, HGRN_CHUNK), dtype=bool))[None, None, :, :, None]

    def chunk_step(state, inp):
        qc, kc, gc, vc = inp
        b = jnp.cumsum(gc, axis=2)
        b_last = b[:, :, -1:, :]
        o_inter = jnp.einsum('bhtk,bhkv->bhtv', qc * jnp.exp(b), state)
        decay = jnp.exp(jnp.where(causal, b[:, :, :, None, :] - b[:, :, None, :, :], -jnp.inf))
        scores = jnp.einsum('bhtk,bhsk,bhtsk->bhts', qc, kc, decay)
        o_intra = jnp.einsum('bhts,bhsv->bhtv', scores, vc)
        new_state = (jnp.exp(b_last[:, :, 0, :])[..., None] * state
                     + jnp.einsum('bhsk,bhsv->bhkv', kc * jnp.exp(b_last - b), vc))
        return new_state, o_inter + o_intra

    state0 = jnp.zeros((bsz, HGRN_HEADS, HGRN_EXPAND, HGRN_HEAD_V), F32)
    _, o = lax.scan(chunk_step, state0, xs)
    o = o.transpose(1, 0, 3, 2, 4).reshape(bsz, seq, HGRN_HEADS, HGRN_HEAD_V)
    o = o * lax.rsqrt(jnp.mean(o * o, axis=-1, keepdims=True) + NORM_EPS)
    o = o.reshape(bsz, seq, HGRN_WIDTH) * g_norm.astype(F32)
    return o * jax.nn.silu(g_raw.astype(F32))


def recurrent_mixers(h, w_in, conv_w, conv_b, w_a, b_a, w_i, b_i, lam, lower_bound, g_norm, w_out):
    proj = h @ w_in
    x_lru, y_lru, q_h, f_h, v_h, g_h = jnp.split(proj, list(IN_SPLITS), axis=-1)
    lru = rg_lru(causal_depthwise_conv(x_lru, conv_w, conv_b), w_a, b_a, w_i, b_i, lam)
    lru = lru * jax.nn.gelu(y_lru.astype(F32), approximate=True)
    hg = hgrn2(q_h, f_h, v_h, g_h, lower_bound, g_norm)
    mixed = jnp.concatenate([lru, hg], axis=-1).astype(h.dtype)
    return mixed @ w_out


def partial_rope(t, positions):
    half = ROPE_DIM // 2
    inv_freq = 1.0 / (ROPE_THETA ** (jnp.arange(half, dtype=F32) * (2.0 / ROPE_DIM)))
    ang = positions.astype(F32)[:, :, None, None] * inv_freq
    cos, sin = jnp.cos(ang), jnp.sin(ang)
    t1 = t[..., :half]
    t2 = t[..., half:ROPE_DIM]
    return jnp.concatenate([t1 * cos - t2 * sin, t2 * cos + t1 * sin, t[..., ROPE_DIM:]], axis=-1)


def dilated_branch(q, k, v, window, dilation):
    bsz, seq, nh, hd = q.shape
    n_dist = window // dilation
    qb = DSWA_BLOCK
    length = seq // dilation
    nb = -(-length // qb)
    lp = nb * qb
    groups = bsz * dilation

    def to_sub(t):
        t = t.reshape(bsz, length, dilation, nh, hd).transpose(0, 2, 3, 1, 4).reshape(groups, nh, length, hd)
        t = jnp.pad(t, ((0, 0), (0, 0), (0, lp - length), (0, 0)))
        return t.reshape(groups, nh, nb, qb, hd)

    def band(t):
        prev = jnp.pad(t, ((0, 0), (0, 0), (1, 0), (0, 0), (0, 0)))[:, :, :-1]
        return jnp.concatenate([prev, t], axis=3)

    def from_sub(t):
        t = t.reshape(groups, nh, lp, -1)[:, :, :length]
        return t.reshape(bsz, dilation, nh, length, -1).transpose(0, 3, 1, 2, 4).reshape(bsz, seq, nh, -1)

    qs = to_sub(q)
    kb = band(to_sub(k))
    vb = band(to_sub(v))
    s = jnp.einsum('ghnqd,ghnkd->ghnqk', qs, kb)
    qi = jnp.arange(qb)[:, None]
    kj = jnp.arange(2 * qb)[None, :]
    dist = qi - kj + qb
    key_idx = jnp.arange(nb)[:, None, None] * qb - qb + kj[None]
    mask = (dist >= 0) & (dist <= n_dist) & (key_idx >= 0)
    s = jnp.where(mask, s, -jnp.inf)
    m = jnp.max(s, axis=-1)
    p = jnp.exp(s - m[..., None])
    l = jnp.sum(p, axis=-1)
    o = jnp.einsum('ghnqk,ghnkd->ghnqd', p, vb)
    return from_sub(m), from_sub(l), from_sub(o)


def dilated_attention(h, positions, w_qkv, w_o):
    bsz, seq, _ = h.shape
    qkv = (h @ w_qkv).astype(F32).reshape(bsz, seq, 3, ATTN_HEADS, HEAD_DIM)
    q = partial_rope(qkv[:, :, 0], positions) * (HEAD_DIM ** -0.5)
    k = partial_rope(qkv[:, :, 1], positions)
    v = qkv[:, :, 2]
    branches = [dilated_branch(q, k, v, w, d) for (w, d) in DILATED_GROUPS]
    m_max = branches[0][0]
    for br in branches[1:]:
        m_max = jnp.maximum(m_max, br[0])
    w0 = jnp.exp(branches[0][0] - m_max)
    num = w0 * branches[0][2]
    den = w0 * branches[0][1]
    for m_b, l_b, o_b in branches[1:]:
        w_b = jnp.exp(m_b - m_max)
        num = num + w_b * o_b
        den = den + w_b * l_b
    out = (num / den).reshape(bsz, seq, D_MODEL).astype(h.dtype)
    return out @ w_o


def squared_relu_mlp(h, w1, w2):
    return jnp.square(jax.nn.relu(h @ w1)) @ w2


def setup_inputs(seed: int = 0) -> dict:
    key = jax.random.key(seed)
    ks = jax.random.split(key, 20)

    def nrm(k, shape, scale):
        return jax.random.normal(k, shape, F32) * scale

    x = nrm(ks[0], (BATCH, SEQ, D_MODEL), 1.0)
    positions = jnp.broadcast_to(jnp.arange(SEQ, dtype=jnp.int32), (BATCH, SEQ))
    norm_mix = 1.0 + nrm(ks[1], (DEPTH, D_MODEL), 0.05)
    norm_mlp = 1.0 + nrm(ks[2], (DEPTH, D_MODEL), 0.05)
    final_norm = 1.0 + nrm(ks[3], (D_MODEL,), 0.05)
    rec_w_in = nrm(ks[4], (N_EVEN, D_MODEL, IN_COLS), D_MODEL ** -0.5)
    rec_conv_w = nrm(ks[5], (N_EVEN, CONV_WIDTH, LRU_WIDTH), CONV_WIDTH ** -0.5)
    rec_conv_b = nrm(ks[6], (N_EVEN, LRU_WIDTH), 0.01)
    lru_w_a = nrm(ks[7], (N_EVEN, LRU_HEADS, LRU_BLOCK, LRU_BLOCK), LRU_BLOCK ** -0.5)
    lru_b_a = nrm(ks[8], (N_EVEN, LRU_WIDTH), 0.01)
    lru_w_i = nrm(ks[9], (N_EVEN, LRU_HEADS, LRU_BLOCK, LRU_BLOCK), LRU_BLOCK ** -0.5)
    lru_b_i = nrm(ks[10], (N_EVEN, LRU_WIDTH), 0.01)
    a_pow_c = jax.random.uniform(ks[11], (N_EVEN, LRU_WIDTH), F32, minval=0.9, maxval=0.999)
    a_base = a_pow_c ** (1.0 / LRU_C)
    lru_lambda = jnp.log(a_base) - jnp.log1p(-a_base)
    hgrn_lb_logits = nrm(ks[12], (DEPTH + 1, HGRN_WIDTH), 0.5)
    hgrn_g_norm = 1.0 + nrm(ks[13], (N_EVEN, HGRN_WIDTH), 0.05)
    rec_w_out = nrm(ks[14], (N_EVEN, D_MODEL, D_MODEL), D_MODEL ** -0.5)
    attn_w_qkv = nrm(ks[15], (N_ODD, D_MODEL, 3 * D_MODEL), D_MODEL ** -0.5)
    attn_w_o = nrm(ks[16], (N_ODD, D_MODEL, D_MODEL), D_MODEL ** -0.5)
    mlp_w1 = nrm(ks[17], (DEPTH, D_MODEL, D_FF), D_MODEL ** -0.5)
    mlp_w2 = nrm(ks[18], (DEPTH, D_FF, D_MODEL), D_FF ** -0.5)
    return {'x': x, 'positions': positions, 'norm_mix': norm_mix, 'norm_mlp': norm_mlp,
            'final_norm': final_norm, 'rec_w_in': rec_w_in, 'rec_conv_w': rec_conv_w,
            'rec_conv_b': rec_conv_b, 'lru_w_a': lru_w_a, 'lru_b_a': lru_b_a,
            'lru_w_i': lru_w_i, 'lru_b_i': lru_b_i, 'lru_lambda': lru_lambda,
            'hgrn_lb_logits': hgrn_lb_logits, 'hgrn_g_norm': hgrn_g_norm,
            'rec_w_out': rec_w_out, 'attn_w_qkv': attn_w_qkv, 'attn_w_o': attn_w_o,
            'mlp_w1': mlp_w1, 'mlp_w2': mlp_w2}


def reference(x, positions, norm_mix, norm_mlp, final_norm, rec_w_in, rec_conv_w, rec_conv_b,
              lru_w_a, lru_b_a, lru_w_i, lru_b_i, lru_lambda, hgrn_lb_logits, hgrn_g_norm,
              rec_w_out, attn_w_qkv, attn_w_o, mlp_w1, mlp_w2):
    lower_bounds = jnp.cumsum(jax.nn.softmax(hgrn_lb_logits.astype(F32), axis=0), axis=0)
    h = x
    for layer in range(DEPTH):
        hn = rms_norm(h, norm_mix[layer])
        j = layer // 2
        if layer % 2 == 0:
            mix = recurrent_mixers(hn, rec_w_in[j], rec_conv_w[j], rec_conv_b[j], lru_w_a[j],
                                   lru_b_a[j], lru_w_i[j], lru_b_i[j], lru_lambda[j],
                                   lower_bounds[layer], hgrn_g_norm[j], rec_w_out[j])
        else:
            mix = dilated_attention(hn, positions, attn_w_qkv[j], attn_w_o[j])
        h = h + mix
        h = h + squared_relu_mlp(rms_norm(h, norm_mlp[layer]), mlp_w1[layer], mlp_w2[layer])
    return rms_norm(h, final_norm)
```

```cpp
#include <hip/hip_runtime.h>
#include <hip/hip_cooperative_groups.h>
#include <cstdio>
namespace cg = cooperative_groups;

#define LAS __attribute__((address_space(3)))
typedef unsigned short bf16_t;
typedef short bf16x8 __attribute__((ext_vector_type(8)));
typedef short s16x4 __attribute__((ext_vector_type(4)));
typedef float f32x4 __attribute__((ext_vector_type(4)));
typedef float f32x2 __attribute__((ext_vector_type(2)));
typedef unsigned u32x4 __attribute__((ext_vector_type(4)));
typedef unsigned u32x2 __attribute__((ext_vector_type(2)));

constexpr int SEQ = 8192, NTOK = 16384, DM = 2048, DFF = 8192, INC = 6144;
constexpr int LDS_BYTES = 144 * 1024;
constexpr size_t MiB = 1024 * 1024;
constexpr size_t WS_WA = 0, WS_WB = 24 * MiB, WS_W1 = 32 * MiB, WS_W2 = 64 * MiB, WS_WG = 96 * MiB;
constexpr size_t WS_AGG = 97 * MiB, WS_DK = 98 * MiB, WS_CTR = 99 * MiB, WS_TAB = 100 * MiB;
constexpr size_t WS_XN = 104 * MiB, WS_BIG = 168 * MiB, WS_LA = WS_BIG + 192 * MiB, WS_LU = 424 * MiB, WS_END = 488 * MiB;

struct Params {
    const float* x; const int* pos; const float* norm_mix; const float* norm_mlp; const float* final_norm;
    const float* w_in; const float* conv_w; const float* conv_b; const float* w_a; const float* b_a; const float* w_i; const float* b_i;
    const float* lam; const float* lb_logits; const float* g_norm; const float* w_out; const float* w_qkv; const float* w_o; const float* w1; const float* w2;
    float* out; unsigned char* ws;
};

typedef __bf16 bf16v2_t __attribute__((ext_vector_type(2)));
__device__ __forceinline__ unsigned pk2(float lo, float hi) { bf16v2_t v; v[0] = (__bf16)lo; v[1] = (__bf16)hi; return __builtin_bit_cast(unsigned, v); }
__device__ __forceinline__ float bf2f(bf16_t b) { return __uint_as_float(((unsigned)b) << 16); }
__device__ __forceinline__ float bflo(unsigned w) { return __uint_as_float(w << 16); }
__device__ __forceinline__ float bfhi(unsigned w) { return __uint_as_float(w & 0xffff0000u); }
__device__ __forceinline__ float sigmoidf_(float x) { return __builtin_amdgcn_rcpf(1.0f + __expf(-x)); }
__device__ __forceinline__ float siluf_(float x) { return x * __builtin_amdgcn_rcpf(1.0f + __expf(-x)); }
__device__ __forceinline__ float gelu_tanh(float y) { const float z = 0.7978845608028654f * (y + 0.044715f * y * y * y); const float t = 1.0f - 2.0f / (__expf(2.0f * z) + 1.0f); return 0.5f * y * (1.0f + t); }
__device__ __forceinline__ float wave_sum(float v) {
#pragma unroll
    for (int o = 1; o < 64; o <<= 1) v += __shfl_xor(v, o);
    return v;
}
__device__ __forceinline__ void lds_wait() { asm volatile("s_waitcnt lgkmcnt(0)" ::: "memory"); }
__device__ __forceinline__ s16x4 tr_read(unsigned lds_addr) { s16x4 r; asm volatile("ds_read_b64_tr_b16 %0, %1\n\ts_waitcnt lgkmcnt(0)" : "=&v"(r) : "v"(lds_addr) : "memory"); return r; }
__device__ __forceinline__ bf16x8 cat8(s16x4 a, s16x4 b) { bf16x8 r; r[0] = a[0]; r[1] = a[1]; r[2] = a[2]; r[3] = a[3]; r[4] = b[0]; r[5] = b[1]; r[6] = b[2]; r[7] = b[3]; return r; }
__device__ __forceinline__ bf16x8 pack8(f32x4 a, f32x4 b) { u32x4 w; w.x = pk2(a[0], a[1]); w.y = pk2(a[2], a[3]); w.z = pk2(b[0], b[1]); w.w = pk2(b[2], b[3]); return __builtin_bit_cast(bf16x8, w); }
__device__ __forceinline__ unsigned lds_addr_of(LAS unsigned char* p) { return (unsigned)(size_t)p; }

namespace pg8 {
constexpr int BM = 256, BK = 64, HALF = 128, HTB = HALF * BK * 2, STAGE_BYTES = 8 * HTB, NXCD = 8, WGM = 4;
__device__ __forceinline__ int lds_byte(int r, int c) { const int st = (r >> 4) * 2 + (c >> 5), rr = r & 15, cc = c & 31, ob = rr * 64 + cc * 2; return st * 1024 + (ob ^ (((ob >> 9) & 1) << 5)); }
__device__ __forceinline__ void stage_rc(int b, int& R, int& C) { const int st = b / 1024, sb = b % 1024, swz = sb ^ (((sb >> 9) & 1) << 5); R = (st >> 1) * 16 + swz / 64; C = (st & 1) * 32 + (swz % 64) / 2; }
__device__ __forceinline__ int perm32(int rho) { const int n = rho >> 4, i = rho & 15; return 8 * (i >> 2) + 4 * n + (i & 3); }

struct Unit { int pm, pn, z, i; };
struct Gemm { const bf16_t* A; const bf16_t* Bt; int lda, ldb, K; size_t a_z, b_z; };
struct Order {
    int nM, nN, nZ, per, G, c;
    __device__ void init(int M, int N, int Z, int G_, int c_) { nM = M / BM; nN = N / BM; nZ = Z; per = nM * nN; G = G_; c = c_; }
    __device__ bool next(int i, Unit& u) const {
        const long L = (long)i * G + c; if (L >= (long)per * nZ) return false;
        const int nwg = per * nZ;
        int wgid = (int)L; { const int q = nwg / NXCD, r = nwg % NXCD, xcd = wgid % NXCD, off = wgid / NXCD; wgid = (xcd < r ? xcd * (q + 1) : r * (q + 1) + (xcd - r) * q) + off; }
        u.z = wgid / per; wgid -= u.z * per;
        const int nig = WGM * nN, gid = wgid / nig, fm = gid * WGM, gsz = (nM - fm) < WGM ? (nM - fm) : WGM;
        u.pm = fm + ((wgid % nig) % gsz); u.pn = (wgid % nig) / gsz; u.i = i; return true;
    }
};

template <class Epi>
__device__ __forceinline__ void gemm_phase(LAS unsigned char* lds, const Gemm g, const Order& S, const Epi& E, const int tid) {
    const int wid = __builtin_amdgcn_readfirstlane(tid >> 6), lane = tid & 63, wr = wid >> 2, wc = wid & 3, fr = lane & 15, fq = lane >> 4;
    const int K = g.K, nt = K / BK;
    unsigned voffA[2], voffB[2];
#pragma unroll
    for (int i = 0; i < 2; ++i) { int R, C; stage_rc(tid * 16 + i * 8192, R, C); const int Rb = Epi::PERM ? ((R & ~31) + perm32(R & 31)) : R;
        voffA[i] = (unsigned)(R * g.lda + C) * 2u; voffB[i] = (unsigned)(Rb * g.ldb + C) * 2u; }
    const size_t kstep = (size_t)(BK * 2);
    const size_t hstepA = (size_t)HALF * g.lda * 2, hstepB = (size_t)HALF * g.ldb * 2;
    const size_t tstepA = 2 * hstepA, tstepB = 2 * hstepB;
    const unsigned ldsw = (unsigned)wid * 1024u;
    const int aoff = lds_byte(wr * 64 + fr, fq * 8), boff = lds_byte(wc * 32 + fr, fq * 8);
#define PG8_SA(b, h) (((b) * 2 + (h)) * HTB)
#define PG8_SB(b, h) ((4 + (b) * 2 + (h)) * HTB)
#define PG8_STAGE(bufoff, gbase, voff) do { _Pragma("unroll") for (int _i = 0; _i < 2; ++_i) \
        __builtin_amdgcn_global_load_lds((const unsigned*)((const char*)(gbase) + (voff)[_i]), (LAS unsigned*)(lds + (bufoff) + ldsw + _i * 8192), 16, 0, 0); } while (0)
#define PG8_LDA(dst, b, h) do { _Pragma("unroll") for (int m = 0; m < 4; ++m) _Pragma("unroll") for (int k = 0; k < 2; ++k) dst[m][k] = *(const LAS bf16x8*)(lds + PG8_SA(b, h) + aoff + m * 2048 + k * 1024); } while (0)
#define PG8_LDB(dst, b, h) do { _Pragma("unroll") for (int n = 0; n < 2; ++n) _Pragma("unroll") for (int k = 0; k < 2; ++k) dst[n][k] = *(const LAS bf16x8*)(lds + PG8_SB(b, h) + boff + n * 2048 + k * 1024); } while (0)
#define PG8_MMA(ai, bj, At, Bt) do { __builtin_amdgcn_s_setprio(1); _Pragma("unroll") for (int m = 0; m < 4; ++m) _Pragma("unroll") for (int n = 0; n < 2; ++n) _Pragma("unroll") for (int k = 0; k < 2; ++k) \
        acc[ai][bj][m][n] = __builtin_amdgcn_mfma_f32_16x16x32_bf16(Bt[n][k], At[m][k], acc[ai][bj][m][n], 0, 0, 0); __builtin_amdgcn_s_setprio(0); } while (0)
#define PG8_WAIT_V(n) asm volatile("s_waitcnt vmcnt(" #n ")" ::: "memory")
#define PG8_WAIT_L(n) asm volatile("s_waitcnt lgkmcnt(" #n ")" ::: "memory")
#define PG8_BAR __builtin_amdgcn_s_barrier()
#define PG8_SCHED __builtin_amdgcn_sched_barrier(0)
    Unit cur, nxt; int ui = 0;
    if (!S.next(0, cur)) return;
    f32x4 acc[2][2][4][2];
#pragma unroll
    for (int a = 0; a < 2; ++a)
#pragma unroll
        for (int b = 0; b < 2; ++b)
#pragma unroll
            for (int m = 0; m < 4; ++m)
#pragma unroll
                for (int n = 0; n < 2; ++n) acc[a][b][m][n] = (f32x4){0.f, 0.f, 0.f, 0.f};
    bf16x8 At[4][2], B0[2][2], B1[2][2];
    const char* cA = (const char*)g.A + (size_t)cur.pm * tstepA + (size_t)cur.z * g.a_z; const char* cB = (const char*)g.Bt + (size_t)cur.pn * tstepB + (size_t)cur.z * g.b_z;
    PG8_STAGE(PG8_SB(0, 0), cB, voffB); PG8_STAGE(PG8_SA(0, 0), cA, voffA); PG8_STAGE(PG8_SB(0, 1), cB + hstepB, voffB); PG8_STAGE(PG8_SA(0, 1), cA + hstepA, voffA);
    if (wr == 1) PG8_BAR;
    PG8_WAIT_V(4); PG8_BAR;
    PG8_STAGE(PG8_SB(1, 0), cB + kstep, voffB); PG8_STAGE(PG8_SA(1, 0), cA + kstep, voffA); PG8_STAGE(PG8_SB(1, 1), cB + hstepB + kstep, voffB);
    PG8_WAIT_V(6); PG8_BAR;
    for (;;) {
        const bool has_next = S.next(ui + 1, nxt);
        const char* nA = has_next ? (const char*)g.A + (size_t)nxt.pm * tstepA + (size_t)nxt.z * g.a_z : cA; const char* nB = has_next ? (const char*)g.Bt + (size_t)nxt.pn * tstepB + (size_t)nxt.z * g.b_z : cB;
        for (int t = 0; t < nt; t += 2) {
            const bool last = (t == nt - 2);
            const char* a1 = cA + (size_t)(t + 1) * kstep;
            const char* a2 = last ? nA : cA + (size_t)(t + 2) * kstep; const char* b2 = last ? nB : cB + (size_t)(t + 2) * kstep;
            const char* a3 = a2 + kstep; const char* b3 = b2 + kstep;
            PG8_LDB(B0, 0, 0); PG8_SCHED; PG8_LDA(At, 0, 0); PG8_STAGE(PG8_SA(1, 1), a1 + hstepA, voffA);
            PG8_WAIT_L(8); PG8_BAR; PG8_WAIT_L(0); PG8_MMA(0, 0, At, B0); PG8_BAR; PG8_SCHED;
            PG8_LDB(B1, 0, 1); PG8_STAGE(PG8_SB(0, 0), b2, voffB);
            PG8_BAR; PG8_WAIT_L(0); PG8_MMA(0, 1, At, B1); PG8_BAR;
            PG8_LDA(At, 0, 1); PG8_STAGE(PG8_SA(0, 0), a2, voffA);
            PG8_BAR; PG8_WAIT_L(0); PG8_MMA(1, 0, At, B0); PG8_BAR; PG8_SCHED;
            PG8_STAGE(PG8_SB(0, 1), b2 + hstepB, voffB);
            PG8_WAIT_V(6); PG8_BAR; PG8_MMA(1, 1, At, B1); PG8_BAR;
            PG8_LDB(B0, 1, 0); PG8_SCHED; PG8_LDA(At, 1, 0); PG8_STAGE(PG8_SA(0, 1), a2 + hstepA, voffA);
            PG8_WAIT_L(8); PG8_BAR; PG8_WAIT_L(0); PG8_MMA(0, 0, At, B0); PG8_BAR; PG8_SCHED;
            PG8_LDB(B1, 1, 1); PG8_STAGE(PG8_SB(1, 0), b3, voffB);
            PG8_BAR; PG8_WAIT_L(0); PG8_MMA(0, 1, At, B1); PG8_BAR;
            PG8_LDA(At, 1, 1); PG8_STAGE(PG8_SA(1, 0), a3, voffA);
            PG8_BAR; PG8_WAIT_L(0); PG8_MMA(1, 0, At, B0); PG8_BAR; PG8_SCHED;
            PG8_STAGE(PG8_SB(1, 1), b3 + hstepB, voffB);
            PG8_WAIT_V(6); PG8_BAR; PG8_MMA(1, 1, At, B1); PG8_BAR;
        }
        E(acc, cur, wr, wc, fr, fq);
        if (!has_next) break;
#pragma unroll
        for (int a = 0; a < 2; ++a)
#pragma unroll
            for (int b = 0; b < 2; ++b)
#pragma unroll
                for (int m = 0; m < 4; ++m)
#pragma unroll
                    for (int n = 0; n < 2; ++n) acc[a][b][m][n] = (f32x4){0.f, 0.f, 0.f, 0.f};
        cur = nxt; cA = nA; cB = nB; ++ui;
    }
    PG8_WAIT_V(0);
    if (wr == 0) PG8_BAR;
    PG8_BAR;
#undef PG8_SA
#undef PG8_SB
#undef PG8_STAGE
#undef PG8_LDA
#undef PG8_LDB
#undef PG8_MMA
#undef PG8_WAIT_V
#undef PG8_WAIT_L
#undef PG8_BAR
#undef PG8_SCHED
}

template <int ACT  , bool RS = false> struct EpiBf16 {
    static constexpr bool PERM = true;
    bf16_t* O; int ldc; const LAS float* rt;
    __device__ __forceinline__ void operator()(const f32x4 (&acc)[2][2][4][2], const Unit& u, int wr, int wc, int fr, int fq) const {
        const int row0 = u.pm * BM + wr * 64 + fr, col0 = u.pn * BM + wc * 32 + 8 * fq;
#pragma unroll
        for (int ai = 0; ai < 2; ++ai)
#pragma unroll
            for (int m = 0; m < 4; ++m) { bf16_t* rowp = O + (size_t)(row0 + ai * HALF + m * 16) * ldc + col0;
                float rs = 1.0f; if (RS) rs = rt[u.i * 256 + wr * 64 + fr + ai * HALF + m * 16];
#pragma unroll
                for (int bj = 0; bj < 2; ++bj) { f32x4 v0 = acc[ai][bj][m][0], v1 = acc[ai][bj][m][1];
                    if (RS) { v0 *= rs; v1 *= rs; }
                    if (ACT == 1) {
#pragma unroll
                        for (int j = 0; j < 4; ++j) { const float a = fmaxf(v0[j], 0.f), b = fmaxf(v1[j], 0.f); v0[j] = a * a; v1[j] = b * b; } }
                    u32x4 w; w.x = pk2(v0[0], v0[1]); w.y = pk2(v0[2], v0[3]); w.z = pk2(v1[0], v1[1]); w.w = pk2(v1[2], v1[3]);
                    *(u32x4*)(rowp + bj * HALF) = w; } }
    }
};
template <bool BASE_F32> struct EpiResidB {
    static constexpr bool PERM = true;
    const float* basef; const bf16_t* baseb; bf16_t* out; float* ssqp;
    __device__ __forceinline__ void operator()(const f32x4 (&acc)[2][2][4][2], const Unit& u, int wr, int wc, int fr, int fq) const {
        const int row0 = u.pm * BM + wr * 64 + fr, col0 = u.pn * BM + wc * 32 + 8 * fq;
#pragma unroll
        for (int ai = 0; ai < 2; ++ai) {
            if (BASE_F32) {
#pragma unroll
                for (int m = 0; m < 4; m += 2) {
                    f32x4 bs[2][2][2];
#pragma unroll
                    for (int mm = 0; mm < 2; ++mm) { const size_t off = (size_t)(row0 + ai * HALF + (m + mm) * 16) * DM + col0;
#pragma unroll
                        for (int bj = 0; bj < 2; ++bj)
#pragma unroll
                            for (int n = 0; n < 2; ++n) bs[mm][bj][n] = *(const f32x4*)(basef + off + bj * HALF + n * 4); }
#pragma unroll
                    for (int mm = 0; mm < 2; ++mm) { const size_t off = (size_t)(row0 + ai * HALF + (m + mm) * 16) * DM + col0;
                        float ss = 0.f;
#pragma unroll
                        for (int bj = 0; bj < 2; ++bj) { const f32x4 v0 = bs[mm][bj][0] + acc[ai][bj][m + mm][0], v1 = bs[mm][bj][1] + acc[ai][bj][m + mm][1];
                            ss += (v0[0] * v0[0] + v0[1] * v0[1]) + (v0[2] * v0[2] + v0[3] * v0[3]) + (v1[0] * v1[0] + v1[1] * v1[1]) + (v1[2] * v1[2] + v1[3] * v1[3]);
                            u32x4 w; w.x = pk2(v0[0], v0[1]); w.y = pk2(v0[2], v0[3]); w.z = pk2(v1[0], v1[1]); w.w = pk2(v1[2], v1[3]);
                            *(u32x4*)(out + off + bj * HALF) = w; }
                        if (ssqp) { ss += __shfl_xor(ss, 16); ss += __shfl_xor(ss, 32); if (fq == 0) ssqp[(size_t)(row0 + ai * HALF + (m + mm) * 16) * 32 + u.pn * 4 + wc] = ss; } }
                    asm volatile("" ::: "memory"); }
            } else {
                u32x4 bs[4][2];
#pragma unroll
                for (int m = 0; m < 4; ++m) { const size_t off = (size_t)(row0 + ai * HALF + m * 16) * DM + col0;
#pragma unroll
                    for (int bj = 0; bj < 2; ++bj) bs[m][bj] = *(const u32x4*)(baseb + off + bj * HALF); }
#pragma unroll
                for (int m = 0; m < 4; ++m) { const size_t off = (size_t)(row0 + ai * HALF + m * 16) * DM + col0;
                    float ss = 0.f;
#pragma unroll
                    for (int bj = 0; bj < 2; ++bj) { const u32x4 q = bs[m][bj]; const f32x4 a0 = acc[ai][bj][m][0], a1 = acc[ai][bj][m][1];
                        const float h0 = bflo(q.x) + a0[0], h1 = bfhi(q.x) + a0[1], h2 = bflo(q.y) + a0[2], h3 = bfhi(q.y) + a0[3], h4 = bflo(q.z) + a1[0], h5 = bfhi(q.z) + a1[1], h6 = bflo(q.w) + a1[2], h7 = bfhi(q.w) + a1[3];
                        ss += (h0 * h0 + h1 * h1) + (h2 * h2 + h3 * h3) + (h4 * h4 + h5 * h5) + (h6 * h6 + h7 * h7);
                        u32x4 w; w.x = pk2(h0, h1); w.y = pk2(h2, h3); w.z = pk2(h4, h5); w.w = pk2(h6, h7);
                        *(u32x4*)(out + off + bj * HALF) = w; }
                    if (ssqp) { ss += __shfl_xor(ss, 16); ss += __shfl_xor(ss, 32); if (fq == 0) ssqp[(size_t)(row0 + ai * HALF + m * 16) * 32 + u.pn * 4 + wc] = ss; } }
                asm volatile("" ::: "memory");
            }
        }
    }
};
struct EpiGates {
    static constexpr bool PERM = false;
    const bf16_t* XC; const float* b_a; const float* b_i; const float* spt; unsigned* LAU;
    __device__ __forceinline__ void operator()(const f32x4 (&acc)[2][2][4][2], const Unit& u, int wr, int wc, int fr, int fq) const {
        const int row0 = u.pm * BM + wr * 64 + fr, ch0 = u.z * 256 + u.pn * 128 + wc * 32 + 4 * fq;
#pragma unroll
        for (int n = 0; n < 2; ++n) {
            const int ch = ch0 + 16 * n;
            u32x2 xw[2][4];
#pragma unroll
            for (int ai = 0; ai < 2; ++ai)
#pragma unroll
                for (int m = 0; m < 4; ++m) xw[ai][m] = *(const u32x2*)(XC + (unsigned)(row0 + ai * HALF + m * 16) * 1024u + (unsigned)ch);
            const f32x4 ba = *(const f32x4*)(b_a + ch), bi = *(const f32x4*)(b_i + ch), sp = *(const f32x4*)(spt + ch);
#pragma unroll
            for (int ai = 0; ai < 2; ++ai)
#pragma unroll
                for (int m = 0; m < 4; ++m) {
                    const unsigned off = (unsigned)(row0 + ai * HALF + m * 16) * 1024u + (unsigned)ch;
                    const float xc[4] = {bflo(xw[ai][m].x), bfhi(xw[ai][m].x), bflo(xw[ai][m].y), bfhi(xw[ai][m].y)};
                    u32x4 w;
#pragma unroll
                    for (int j = 0; j < 4; ++j) {
                        const float r = sigmoidf_(acc[ai][0][m][n][j] + ba[j]), ig = sigmoidf_(acc[ai][1][m][n][j] + bi[j]);
                        const float la = sp[j] * r, x2 = 2.0f * la;
                        const float ser = -x2 * (1.0f + x2 * (0.5f + x2 * (0.16666667f + x2 * (0.041666668f + x2 * 0.0083333338f))));
                        const float om = (x2 > -0.25f) ? ser : (1.0f - __expf(x2));
                        w[j] = pk2(la, __builtin_amdgcn_sqrtf(om) * ig * xc[j]);
                    }
                    *(u32x4*)(LAU + off) = w;
                }
        }
    }
};
struct EpiQkv {
    static constexpr bool PERM = false;
    bf16_t* O; const float* tab; const LAS float* rt;
    __device__ __forceinline__ void operator()(f32x4 (&acc)[2][2][4][2], const Unit& u, int wr, int wc, int fr, int fq) const {
        const int row0 = u.pm * BM + wr * 64 + fr, col0 = u.pn * BM + wc * 32 + 4 * fq;
        const int sec = u.pn >> 3;
        const float scale = (sec == 0) ? 0.08838834764831845f : 1.0f;
#pragma unroll
        for (int ai = 0; ai < 2; ++ai)
#pragma unroll
            for (int m = 0; m < 4; ++m) {
                const int row = row0 + ai * HALF + m * 16;
                if (sec < 2 && wc == 0) {
                    const f32x4 t0 = *(const f32x4*)(tab + (size_t)row * 32 + 8 * fq), t1 = *(const f32x4*)(tab + (size_t)row * 32 + 8 * fq + 4);
                    const float cs[4] = {t0[0], t0[2], t1[0], t1[2]}, sn[4] = {t0[1], t0[3], t1[1], t1[3]};
#pragma unroll
                    for (int bj = 0; bj < 2; ++bj)
#pragma unroll
                        for (int j = 0; j < 4; ++j) { const float a = acc[ai][bj][m][0][j], b = acc[ai][bj][m][1][j];
                            acc[ai][bj][m][0][j] = a * cs[j] - b * sn[j]; acc[ai][bj][m][1][j] = b * cs[j] + a * sn[j]; }
                }
                bf16_t* rowp = O + (size_t)row * INC + col0;
#pragma unroll
                for (int bj = 0; bj < 2; ++bj)
#pragma unroll
                    for (int n = 0; n < 2; ++n) { const f32x4 v = acc[ai][bj][m][n] * (scale * rt[u.i * 256 + wr * 64 + fr + ai * HALF + m * 16]); u32x2 w; w.x = pk2(v[0], v[1]); w.y = pk2(v[2], v[3]); *(u32x2*)(rowp + bj * HALF + n * 16) = w; }
            }
    }
};
}

__device__ __forceinline__ void transpose_item(const float* W, int K, int N, bf16_t* WT, int gate, const float* kscale, LAS float* scr, int item, int lane) {
    const int nblk = N / 64, kb = item / nblk, nb = item % nblk, k0 = 64 * kb, n0 = 64 * nb;
    const int c4 = (lane & 15) * 4, kr = lane >> 4;
    f32x4 v[16];
#pragma unroll
    for (int i = 0; i < 16; ++i) v[i] = __builtin_nontemporal_load((const f32x4*)(W + (size_t)(k0 + 4 * i + kr) * N + n0 + c4));
#pragma unroll
    for (int i = 0; i < 16; ++i) { LAS float* d = scr + (4 * i + kr) * 65 + c4; d[0] = v[i][0]; d[1] = v[i][1]; d[2] = v[i][2]; d[3] = v[i][3]; }
    lds_wait();
    const int c = lane & 7;
    f32x4 k0v = {1.f, 1.f, 1.f, 1.f}, k1v = k0v;
    if (kscale) { k0v = *(const f32x4*)(kscale + k0 + 8 * c); k1v = *(const f32x4*)(kscale + k0 + 8 * c + 4); }
#pragma unroll
    for (int j = 0; j < 8; ++j) { const int n = (lane >> 3) + 8 * j; const LAS float* s = scr + (8 * c) * 65 + n;
        u32x4 o; o.x = pk2(s[0 * 65] * k0v[0], s[1 * 65] * k0v[1]); o.y = pk2(s[2 * 65] * k0v[2], s[3 * 65] * k0v[3]); o.z = pk2(s[4 * 65] * k1v[0], s[5 * 65] * k1v[1]); o.w = pk2(s[6 * 65] * k1v[2], s[7 * 65] * k1v[3]);
        const int nn = n0 + n; const int row = gate < 0 ? nn : (256 * (nn >> 7) + 128 * gate + (nn & 127));
        *(u32x4*)(WT + (size_t)row * K + k0 + 8 * c) = o; }
    lds_wait();
}
__device__ __forceinline__ void transpose_job(const float* W, int K, int N, bf16_t* WT, int gate, const float* kscale, LAS unsigned char* lds, int gw, int NGW, int wave, int lane) {
    LAS float* scr = (LAS float*)(lds + wave * 16640);
    const int items = (K / 64) * (N / 64);
    for (int it = gw; it < items; it += NGW) transpose_item(W, K, N, WT, gate, kscale, scr, it, lane);
}
__device__ __forceinline__ void norm_rows_bf16(const float* X, const float* gain, bf16_t* O, int gw, int NGW, int lane) {
    for (int m = gw; m < NTOK; m += NGW) {
        const f32x4* xr = (const f32x4*)(X + (size_t)m * DM) + lane;
        f32x4 v[8]; float s = 0.f;
#pragma unroll
        for (int j = 0; j < 8; ++j) { v[j] = __builtin_nontemporal_load(xr + 64 * j); s += (v[j].x * v[j].x + v[j].y * v[j].y) + (v[j].z * v[j].z + v[j].w * v[j].w); }
        const float rstd = 1.0f / sqrtf(wave_sum(s) * (1.0f / DM) + 1e-6f);
        u32x2* o8 = (u32x2*)(O + (size_t)m * DM) + lane;
#pragma unroll
        for (int j = 0; j < 8; ++j) { const f32x4 g = ((const f32x4*)gain)[lane + 64 * j]; u32x2 w; w.x = pk2(v[j].x * rstd * g.x, v[j].y * rstd * g.y); w.y = pk2(v[j].z * rstd * g.z, v[j].w * rstd * g.w); o8[64 * j] = w; }
    }
}
template <bool OUT_F32>
__device__ __forceinline__ void norm_rows_from_bf16(const bf16_t* H, const float* gain, bf16_t* OB, float* OF, int gw, int NGW, int lane) {
    for (int m = gw; m < NTOK; m += NGW) {
        const u32x4* hr = (const u32x4*)(H + (size_t)m * DM) + lane;
        u32x4 q[4]; float v[4][8]; float s = 0.f;
#pragma unroll
        for (int j = 0; j < 4; ++j) q[j] = __builtin_nontemporal_load(hr + 64 * j);
#pragma unroll
        for (int j = 0; j < 4; ++j) { v[j][0] = bflo(q[j].x); v[j][1] = bfhi(q[j].x); v[j][2] = bflo(q[j].y); v[j][3] = bfhi(q[j].y); v[j][4] = bflo(q[j].z); v[j][5] = bfhi(q[j].z); v[j][6] = bflo(q[j].w); v[j][7] = bfhi(q[j].w);
#pragma unroll
            for (int e = 0; e < 8; ++e) s += v[j][e] * v[j][e]; }
        const float rstd = 1.0f / sqrtf(wave_sum(s) * (1.0f / DM) + 1e-6f);
#pragma unroll
        for (int j = 0; j < 4; ++j) {
            const int c0 = 8 * (lane + 64 * j);
            const f32x4 g0 = *(const f32x4*)(gain + c0), g1 = *(const f32x4*)(gain + c0 + 4);
            const float o0 = v[j][0] * rstd * g0[0], o1 = v[j][1] * rstd * g0[1], o2 = v[j][2] * rstd * g0[2], o3 = v[j][3] * rstd * g0[3];
            const float o4 = v[j][4] * rstd * g1[0], o5 = v[j][5] * rstd * g1[1], o6 = v[j][6] * rstd * g1[2], o7 = v[j][7] * rstd * g1[3];
            if (OUT_F32) { float* op = OF + (size_t)m * DM + c0; __builtin_nontemporal_store((f32x4){o0, o1, o2, o3}, (f32x4*)op); __builtin_nontemporal_store((f32x4){o4, o5, o6, o7}, (f32x4*)(op + 4)); }
            else { u32x4 w; w.x = pk2(o0, o1); w.y = pk2(o2, o3); w.z = pk2(o4, o5); w.w = pk2(o6, o7); *(u32x4*)(OB + (size_t)m * DM + c0) = w; }
        }
    }
}
__device__ __forceinline__ void norm_rows_f32_inplace(float* X, const float* gain, int gw, int NGW, int lane) {
    for (int m = gw; m < NTOK; m += NGW) {
        f32x4* xr = (f32x4*)(X + (size_t)m * DM) + lane;
        f32x4 v[8]; float s = 0.f;
#pragma unroll
        for (int j = 0; j < 8; ++j) { v[j] = xr[64 * j]; s += (v[j].x * v[j].x + v[j].y * v[j].y) + (v[j].z * v[j].z + v[j].w * v[j].w); }
        const float rstd = 1.0f / sqrtf(wave_sum(s) * (1.0f / DM) + 1e-6f);
#pragma unroll
        for (int j = 0; j < 8; ++j) { const f32x4 g = ((const f32x4*)gain)[lane + 64 * j]; xr[64 * j] = v[j] * rstd * g; }
    }
}

constexpr int HP = 136;
__device__ __forceinline__ bf16x8 tr_frag(unsigned base, int rowbase, int col0, int lane) {
    const int g = lane >> 4, idx = lane & 15, q = idx >> 2, p = idx & 3;
    const unsigned a0 = base + (unsigned)(((rowbase + 8 * g + q) * HP + col0 + 4 * p) * 2);
    const s16x4 lo = tr_read(a0), hi = tr_read(a0 + 4 * HP * 2);
    return cat8(lo, hi);
}

struct QTile { bf16x8 q[4]; f32x4 o[8]; float m, l; };
struct KVRegs { u32x4 k[8], v[8]; };

#define TR8(r, base, o0) asm volatile( \
    "ds_read_b64_tr_b16 %0, %8 offset:" #o0 "+0\n\tds_read_b64_tr_b16 %1, %8 offset:" #o0 "+4352\n\t" \
    "ds_read_b64_tr_b16 %2, %8 offset:" #o0 "+32\n\tds_read_b64_tr_b16 %3, %8 offset:" #o0 "+4384\n\t" \
    "ds_read_b64_tr_b16 %4, %8 offset:" #o0 "+64\n\tds_read_b64_tr_b16 %5, %8 offset:" #o0 "+4416\n\t" \
    "ds_read_b64_tr_b16 %6, %8 offset:" #o0 "+96\n\tds_read_b64_tr_b16 %7, %8 offset:" #o0 "+4448\n\t" \
    "s_waitcnt lgkmcnt(0)" \
    : "=&v"(r[0]), "=&v"(r[1]), "=&v"(r[2]), "=&v"(r[3]), "=&v"(r[4]), "=&v"(r[5]), "=&v"(r[6]), "=&v"(r[7]) : "v"(base) : "memory")

#define TR8B(r, base, o0) asm volatile( \
    "ds_read_b64_tr_b16 %0, %8 offset:" #o0 "+0\n\tds_read_b64_tr_b16 %1, %8 offset:" #o0 "+1088\n\t" \
    "ds_read_b64_tr_b16 %2, %8 offset:" #o0 "+32\n\tds_read_b64_tr_b16 %3, %8 offset:" #o0 "+1120\n\t" \
    "ds_read_b64_tr_b16 %4, %8 offset:" #o0 "+64\n\tds_read_b64_tr_b16 %5, %8 offset:" #o0 "+1152\n\t" \
    "ds_read_b64_tr_b16 %6, %8 offset:" #o0 "+96\n\tds_read_b64_tr_b16 %7, %8 offset:" #o0 "+1184\n\t" \
    "s_waitcnt lgkmcnt(0)" \
    : "=&v"(r[0]), "=&v"(r[1]), "=&v"(r[2]), "=&v"(r[3]), "=&v"(r[4]), "=&v"(r[5]), "=&v"(r[6]), "=&v"(r[7]) : "v"(base) : "memory")

__device__ __forceinline__ void attn_tile_update(QTile& t, const int mq, int mk0, unsigned VSa, LAS unsigned char* KS, int lane) {
    const int fr = lane & 15, fq = lane >> 4;
    f32x4 s0 = {0.f, 0.f, 0.f, 0.f}, s1 = {0.f, 0.f, 0.f, 0.f};
#pragma unroll
    for (int kk = 0; kk < 4; ++kk) {
        const bf16x8 a0 = *(const LAS bf16x8*)(KS + ((fr)*HP + 32 * kk + 8 * fq) * 2);
        const bf16x8 a1 = *(const LAS bf16x8*)(KS + ((16 + fr) * HP + 32 * kk + 8 * fq) * 2);
        s0 = __builtin_amdgcn_mfma_f32_16x16x32_bf16(a0, t.q[kk], s0, 0, 0, 0);
        s1 = __builtin_amdgcn_mfma_f32_16x16x32_bf16(a1, t.q[kk], s1, 0, 0, 0);
    }
    const float NEG = -__builtin_inff();
    float mx = NEG;
    bool v0[4], v1[4];
#pragma unroll
    for (int j = 0; j < 4; ++j) {
        const int mk = mk0 + 4 * fq + j, jd = mq - mk;
        v0[j] = (jd >= 0) && (jd <= 128) && (mk >= 0);
        v1[j] = (jd - 16 >= 0) && (jd - 16 <= 128) && (mk + 16 >= 0);
        if (v0[j]) mx = fmaxf(mx, s0[j]);
        if (v1[j]) mx = fmaxf(mx, s1[j]);
    }
    mx = fmaxf(mx, __shfl_xor(mx, 16)); mx = fmaxf(mx, __shfl_xor(mx, 32));
    const float mnew = fmaxf(t.m, mx);
    const float muse = (mnew == NEG) ? 0.f : mnew;
    const float alpha = __expf(t.m - muse);
    f32x4 p0, p1; float ps = 0.f;
#pragma unroll
    for (int j = 0; j < 4; ++j) { p0[j] = v0[j] ? __expf(s0[j] - muse) : 0.f; p1[j] = v1[j] ? __expf(s1[j] - muse) : 0.f; ps += p0[j] + p1[j]; }
    t.l = t.l * alpha + ps; t.m = mnew;
#pragma unroll
    for (int dt = 0; dt < 8; ++dt) t.o[dt] *= alpha;
    const bf16x8 pf = pack8(p0, p1);
    const unsigned vb = VSa + (unsigned)(((4 * fq + (fr >> 2)) * HP + 4 * (fr & 3)) * 2);
    s16x4 ra[8], rb[8];
    TR8(ra, vb, 0);
    TR8(rb, vb, 128);
#pragma unroll
    for (int dt = 0; dt < 4; ++dt) t.o[dt] = __builtin_amdgcn_mfma_f32_16x16x32_bf16(cat8(ra[2 * dt], ra[2 * dt + 1]), pf, t.o[dt], 0, 0, 0);
#pragma unroll
    for (int dt = 0; dt < 4; ++dt) t.o[4 + dt] = __builtin_amdgcn_mfma_f32_16x16x32_bf16(cat8(rb[2 * dt], rb[2 * dt + 1]), pf, t.o[4 + dt], 0, 0, 0);
}

__device__ __forceinline__ void attn_pair_update(QTile& t0, const int mq0, QTile& t1, const int mq1, int mk0, unsigned VSa, LAS unsigned char* KS, int lane) {
    const int fr = lane & 15, fq = lane >> 4;
    f32x4 s00 = {0.f, 0.f, 0.f, 0.f}, s01 = s00, s10 = s00, s11 = s00;
#pragma unroll
    for (int kk = 0; kk < 4; ++kk) {
        const bf16x8 a0 = *(const LAS bf16x8*)(KS + ((fr)*HP + 32 * kk + 8 * fq) * 2);
        const bf16x8 a1 = *(const LAS bf16x8*)(KS + ((16 + fr) * HP + 32 * kk + 8 * fq) * 2);
        s00 = __builtin_amdgcn_mfma_f32_16x16x32_bf16(a0, t0.q[kk], s00, 0, 0, 0);
        s01 = __builtin_amdgcn_mfma_f32_16x16x32_bf16(a1, t0.q[kk], s01, 0, 0, 0);
        s10 = __builtin_amdgcn_mfma_f32_16x16x32_bf16(a0, t1.q[kk], s10, 0, 0, 0);
        s11 = __builtin_amdgcn_mfma_f32_16x16x32_bf16(a1, t1.q[kk], s11, 0, 0, 0);
    }
    const float NEG = -__builtin_inff();
    float mx0 = NEG, mx1 = NEG;
#pragma unroll
    for (int j = 0; j < 4; ++j) {
        const int mk = mk0 + 4 * fq + j, jd0 = mq0 - mk, jd1 = mq1 - mk;
        const bool kv0 = (mk >= 0), kv1 = (mk + 16 >= 0);
        if (!((jd0 >= 0) && (jd0 <= 128) && kv0)) s00[j] = NEG;
        if (!((jd0 - 16 >= 0) && (jd0 - 16 <= 128) && kv1)) s01[j] = NEG;
        if (!((jd1 >= 0) && (jd1 <= 128) && kv0)) s10[j] = NEG;
        if (!((jd1 - 16 >= 0) && (jd1 - 16 <= 128) && kv1)) s11[j] = NEG;
        mx0 = fmaxf(mx0, fmaxf(s00[j], s01[j])); mx1 = fmaxf(mx1, fmaxf(s10[j], s11[j]));
    }
    { const float a = __shfl_xor(mx0, 16), b = __shfl_xor(mx1, 16); mx0 = fmaxf(mx0, a); mx1 = fmaxf(mx1, b); }
    { const float a = __shfl_xor(mx0, 32), b = __shfl_xor(mx1, 32); mx0 = fmaxf(mx0, a); mx1 = fmaxf(mx1, b); }
    const float mn0 = fmaxf(t0.m, mx0), mn1 = fmaxf(t1.m, mx1);
    const float mu0 = (mn0 == NEG) ? 0.f : mn0, mu1 = (mn1 == NEG) ? 0.f : mn1;
    const float al0 = __expf(t0.m - mu0), al1 = __expf(t1.m - mu1);
    f32x4 p00, p01, p10, p11; float ps0 = 0.f, ps1 = 0.f;
#pragma unroll
    for (int j = 0; j < 4; ++j) {
        p00[j] = __expf(s00[j] - mu0); p01[j] = __expf(s01[j] - mu0); p10[j] = __expf(s10[j] - mu1); p11[j] = __expf(s11[j] - mu1);
        ps0 += p00[j] + p01[j]; ps1 += p10[j] + p11[j];
    }
    t0.l = t0.l * al0 + ps0; t0.m = mn0; t1.l = t1.l * al1 + ps1; t1.m = mn1;
#pragma unroll
    for (int dt = 0; dt < 8; ++dt) { t0.o[dt] *= al0; t1.o[dt] *= al1; }
    const bf16x8 pf0 = pack8(p00, p01), pf1 = pack8(p10, p11);
    const unsigned vb = VSa + (unsigned)(((4 * fq + (fr >> 2)) * HP + 4 * (fr & 3)) * 2);
    s16x4 ra[8];
    TR8(ra, vb, 0);
#pragma unroll
    for (int dt = 0; dt < 4; ++dt) { const bf16x8 vf = cat8(ra[2 * dt], ra[2 * dt + 1]);
        t0.o[dt] = __builtin_amdgcn_mfma_f32_16x16x32_bf16(vf, pf0, t0.o[dt], 0, 0, 0); t1.o[dt] = __builtin_amdgcn_mfma_f32_16x16x32_bf16(vf, pf1, t1.o[dt], 0, 0, 0); }
    s16x4 rb[8];
    TR8(rb, vb, 128);
#pragma unroll
    for (int dt = 0; dt < 4; ++dt) { const bf16x8 vf = cat8(rb[2 * dt], rb[2 * dt + 1]);
        t0.o[4 + dt] = __builtin_amdgcn_mfma_f32_16x16x32_bf16(vf, pf0, t0.o[4 + dt], 0, 0, 0); t1.o[4 + dt] = __builtin_amdgcn_mfma_f32_16x16x32_bf16(vf, pf1, t1.o[4 + dt], 0, 0, 0); }
}

__device__ __forceinline__ void attn_load(KVRegs& R, const bf16_t* QKV, int b, int h, int dsh, int rd, int mk0, int lane) {
#pragma unroll
    for (int it = 0; it < 8; ++it) {
        const int kidx = 4 * it + (lane >> 4), ch = lane & 15;
        int mk = mk0 + kidx; mk = mk < 0 ? 0 : mk;
        const size_t row = (size_t)b * SEQ + ((size_t)mk << dsh) + rd;
        R.k[it] = *(const u32x4*)(QKV + row * INC + 2048 + h * 128 + 8 * ch);
        R.v[it] = *(const u32x4*)(QKV + row * INC + 4096 + h * 128 + 8 * ch);
    }
}
__device__ __forceinline__ void attn_stage(const KVRegs& R, LAS unsigned char* KS, LAS unsigned char* VS, int lane) {
#pragma unroll
    for (int it = 0; it < 8; ++it) {
        const int kidx = 4 * it + (lane >> 4), ch = lane & 15;
        *(LAS u32x4*)(KS + (kidx * HP + 8 * ch) * 2) = R.k[it];
        *(LAS u32x4*)(VS + (kidx * HP + 8 * ch) * 2) = R.v[it];
    }
    lds_wait();
}
template <bool T0, bool T1>
__device__ __forceinline__ void attn_branch(const bf16_t* QKV, int b, int h, int n, int dsh, int rd, int mkbase, int ng, QTile& t0, int r0, QTile& t1, int r1, LAS unsigned char* KS, LAS unsigned char* VS, int lane) {
    int g = 0;
    while (g < ng && mkbase + 32 * g + 31 < 0) ++g;
    if (g >= ng) return;
    KVRegs R;
    attn_load(R, QKV, b, h, dsh, rd, mkbase + 32 * g, lane);
    const unsigned VSa = lds_addr_of(VS);
#pragma unroll 1
    for (; g < ng; ++g) {
        const int mk0 = mkbase + 32 * g;
        attn_stage(R, KS, VS, lane);
        if (g + 1 < ng) attn_load(R, QKV, b, h, dsh, rd, mk0 + 32, lane);
        const int mqa = (256 * n + 16 * (lane & 15) + r0 - rd) >> dsh, mqb = (256 * n + 16 * (lane & 15) + r1 - rd) >> dsh;
        if (T0 && T1) attn_pair_update(t0, mqa, t1, mqb, mk0, VSa, KS, lane);
        else if (T0) attn_tile_update(t0, mqa, mk0, VSa, KS, lane);
        else attn_tile_update(t1, mqb, mk0, VSa, KS, lane);
        lds_wait();
    }
}

__device__ __forceinline__ void attn_tile_init(QTile& t, const bf16_t* QKV, int b, int h, int n, int r, int lane) {
    const int fr = lane & 15, fq = lane >> 4;
    const size_t row = (size_t)b * SEQ + 256 * n + 16 * fr + r;
#pragma unroll
    for (int kk = 0; kk < 4; ++kk) t.q[kk] = *(const bf16x8*)(QKV + row * INC + h * 128 + 32 * kk + 8 * fq);
#pragma unroll
    for (int dt = 0; dt < 8; ++dt) t.o[dt] = (f32x4){0.f, 0.f, 0.f, 0.f};
    t.m = -__builtin_inff(); t.l = 0.f;
}
__device__ __forceinline__ unsigned ex_off(int p, int dt, int fq) { return (unsigned)(p * 528 + ((dt ^ ((p >> 4) & 7)) * 64) + fq * 16); }
__device__ __forceinline__ void attn_q_load(QTile& t, const bf16_t* QKV, size_t row, int h, int lane) {
    const int fq = lane >> 4;
#pragma unroll
    for (int kk = 0; kk < 4; ++kk) t.q[kk] = *(const bf16x8*)(QKV + row * INC + h * 128 + 32 * kk + 8 * fq);
}
__device__ __forceinline__ void attn_dump(QTile& t, LAS unsigned char* lds, int p, int lane) {
    asm volatile("" : "+v"(p));
    const int fq = lane >> 4;
    float l = t.l; l += __shfl_xor(l, 16); l += __shfl_xor(l, 32);
#pragma unroll
    for (int dt = 0; dt < 8; ++dt) *(LAS f32x4*)(lds + ex_off(p, dt, fq)) = t.o[dt];
    if (fq == 0) *(LAS f32x2*)(lds + 135168 + p * 8) = (f32x2){t.m, l};
}
__device__ __forceinline__ void attn_pick(QTile& t, LAS unsigned char* lds, int p, int lane) {
    asm volatile("" : "+v"(p));
    const int fq = lane >> 4;
#pragma unroll
    for (int dt = 0; dt < 8; ++dt) t.o[dt] = *(const LAS f32x4*)(lds + ex_off(p, dt, fq));
    const f32x2 ml = *(const LAS f32x2*)(lds + 135168 + p * 8);
    t.m = ml.x; t.l = ml.y * 0.25f;
}
__device__ __forceinline__ void attn_tile_store(QTile& t, bf16_t* ATT, int b, int h, int n, int r, int lane) {
    const int fr = lane & 15, fq = lane >> 4;
    float l = t.l; l += __shfl_xor(l, 16); l += __shfl_xor(l, 32);
    const float inv = 1.0f / l;
    const size_t row = (size_t)b * SEQ + 256 * n + 16 * fr + r;
#pragma unroll
    for (int dt = 0; dt < 8; ++dt) { const f32x4 v = t.o[dt] * inv; u32x2 w; w.x = pk2(v[0], v[1]); w.y = pk2(v[2], v[3]); *(u32x2*)(ATT + row * DM + h * 128 + 16 * dt + 4 * fq) = w; }
}

__device__ __forceinline__ void fill_rstd_table(LAS float* RT, const float* SSQP, const pg8::Order& S, int tid) {
    pg8::Unit uu;
    for (int i = 0; S.next(i, uu); ++i) {
        if (tid < 256) {
            const f32x4* pp = (const f32x4*)(SSQP + (size_t)(uu.pm * 256 + tid) * 32);
            float sacc = 0.f;
#pragma unroll
            for (int q = 0; q < 8; ++q) { const f32x4 v = pp[q]; sacc += (v[0] + v[1]) + (v[2] + v[3]); }
            RT[i * 256 + tid] = 1.0f / sqrtf(sacc * (1.0f / DM) + 1e-6f);
        }
    }
    __syncthreads();
}

__device__ __forceinline__ void grid_barrier(unsigned* ctr, unsigned target, int wave) {
    int lane; asm volatile("v_mbcnt_lo_u32_b32 %0, -1, 0\n\tv_mbcnt_hi_u32_b32 %0, -1, %0" : "=v"(lane));
    asm volatile("s_waitcnt vmcnt(0) lgkmcnt(0)" ::: "memory");
    __syncthreads();
    if (wave == 0) {
        __builtin_amdgcn_fence(__ATOMIC_RELEASE, "agent");
        if (lane == 0) {
            __hip_atomic_fetch_add(ctr, 1u, __ATOMIC_RELEASE, __HIP_MEMORY_SCOPE_AGENT);
            while (__hip_atomic_load(ctr, __ATOMIC_RELAXED, __HIP_MEMORY_SCOPE_AGENT) < target) __builtin_amdgcn_s_sleep(1);
        }
        __builtin_amdgcn_fence(__ATOMIC_ACQUIRE, "agent");
        asm volatile("s_waitcnt vmcnt(0)" ::: "memory");
    }
    __syncthreads();
}

__global__ void __launch_bounds__(512, 2) mega(Params p, int ph_lo, int ph_hi) {
    extern __shared__ __attribute__((aligned(16))) unsigned char lds_raw[];
    LAS unsigned char* lds = (LAS unsigned char*)lds_raw;
    cg::grid_group grid = cg::this_grid();
    const int wave = __builtin_amdgcn_readfirstlane(threadIdx.x >> 6);
    const int G = gridDim.x, bid = blockIdx.x;
    const int gw = bid * 8 + wave, NGW = G * 8;
    const int NGT = G * 512;
    unsigned char* ws = p.ws;
    bf16_t* WA = (bf16_t*)(ws + WS_WA); bf16_t* WB = (bf16_t*)(ws + WS_WB); bf16_t* W1 = (bf16_t*)(ws + WS_W1); bf16_t* W2 = (bf16_t*)(ws + WS_W2); bf16_t* WG = (bf16_t*)(ws + WS_WG);
    f32x2* AGG = (f32x2*)(ws + WS_AGG); float* DK = (float*)(ws + WS_DK); float* TAB = (float*)(ws + WS_TAB);
    bf16_t* XN = (bf16_t*)(ws + WS_XN); bf16_t* BIG = (bf16_t*)(ws + WS_BIG); float* SSQP = (float*)(ws + WS_TAB + 2 * MiB); LAS float* RT = (LAS float*)(lds + pg8::STAGE_BYTES);
    unsigned* LAU = (unsigned*)(ws + WS_LA); bf16_t* HB = (bf16_t*)(ws + WS_LU);
    bf16_t* SSTB = (bf16_t*)p.out;
    if (bid == 0 && threadIdx.x == 0) __hip_atomic_store((unsigned*)(ws + WS_CTR), 0u, __ATOMIC_RELEASE, __HIP_MEMORY_SCOPE_AGENT);
    grid.sync();
    int ph = 0, nbar = 0;
    unsigned* CTR = (unsigned*)(ws + WS_CTR); float* SPT = (float*)(ws + WS_CTR + 4096);
#ifndef DUPMASK
#define DUPMASK 0
#endif
#define PHASE_BEGIN if (ph >= ph_lo && ph < ph_hi) { for (int rep = 0; rep <= ((DUPMASK >> ph) & 1); ++rep) { if (ph > ph_lo || rep > 0) { \
        ++nbar; grid_barrier(CTR, (unsigned)nbar * (unsigned)G, wave); } \
    int lane; asm volatile("v_mbcnt_lo_u32_b32 %0, -1, 0\n\tv_mbcnt_hi_u32_b32 %0, -1, %0" : "=v"(lane)); const int tid = wave * 64 + lane; const int gt = bid * 512 + tid; (void)gt;
#define PHASE_END } } ++ph;

    PHASE_BEGIN
        transpose_job(p.w_in, DM, INC, WA, -1, nullptr, lds, gw, NGW, wave, lane);
#pragma unroll 1
        for (int hh = 0; hh < 4; ++hh) {
            transpose_job(p.w_a + (size_t)hh * 65536, 256, 256, WG + (size_t)hh * 131072, 0, nullptr, lds, gw, NGW, wave, lane);
            transpose_job(p.w_i + (size_t)hh * 65536, 256, 256, WG + (size_t)hh * 131072, 1, nullptr, lds, gw, NGW, wave, lane);
        }
        transpose_job(p.w_out, DM, DM, WB, -1, nullptr, lds, gw, NGW, wave, lane);
        transpose_job(p.w1, DM, DFF, W1, -1, p.norm_mlp, lds, gw, NGW, wave, lane);
        transpose_job(p.w2, DFF, DM, W2, -1, nullptr, lds, gw, NGW, wave, lane);
        norm_rows_bf16(p.x, p.norm_mix, XN, gw, NGW, lane);
        if (gt < 1024) SPT[gt] = -8.0f * log1pf(__expf(-p.lam[gt]));
    PHASE_END

    PHASE_BEGIN
        pg8::Gemm g{XN, WA, DM, DM, DM, 0, 0}; pg8::Order S; S.init(NTOK, INC, 1, G, bid);
        pg8::EpiBf16<0> E{BIG, INC, nullptr};
        pg8::gemm_phase(lds, g, S, E, tid);
    PHASE_END

    PHASE_BEGIN
        for (int idx = gt; idx < NTOK * 128; idx += NGT) {
            const int t = idx >> 7, c8 = (idx & 127) * 8, pos = t & (SEQ - 1);
            float a[8];
            { const f32x4 b0 = *(const f32x4*)(p.conv_b + c8), b1 = *(const f32x4*)(p.conv_b + c8 + 4); a[0] = b0[0]; a[1] = b0[1]; a[2] = b0[2]; a[3] = b0[3]; a[4] = b1[0]; a[5] = b1[1]; a[6] = b1[2]; a[7] = b1[3]; }
#pragma unroll
            for (int j = 0; j < 4; ++j) {
                if (pos - 3 + j >= 0) {
                    const u32x4 xw = *(const u32x4*)(BIG + (size_t)(t - 3 + j) * INC + c8);
                    const f32x4 w0 = *(const f32x4*)(p.conv_w + j * 1024 + c8), w1 = *(const f32x4*)(p.conv_w + j * 1024 + c8 + 4);
                    a[0] += w0[0] * bflo(xw.x); a[1] += w0[1] * bfhi(xw.x); a[2] += w0[2] * bflo(xw.y); a[3] += w0[3] * bfhi(xw.y);
                    a[4] += w1[0] * bflo(xw.z); a[5] += w1[1] * bfhi(xw.z); a[6] += w1[2] * bflo(xw.w); a[7] += w1[3] * bfhi(xw.w);
                }
            }
            u32x4 o; o.x = pk2(a[0], a[1]); o.y = pk2(a[2], a[3]); o.z = pk2(a[4], a[5]); o.w = pk2(a[6], a[7]);
            *(u32x4*)(XN + (size_t)t * 1024 + c8) = o;
        }
        {
            LAS unsigned char* KT = lds; LAS unsigned char* VS = lds + 64 * HP * 2; LAS float* EX = (LAS float*)(lds + 2 * 64 * HP * 2);
            const int k = tid & 127, I = tid >> 7;
            const int fr = lane & 15, fq = lane >> 4;
            for (int unit = bid; unit < 2048; unit += G) {
                const int c = unit & 127, bh = unit >> 7, h = bh & 7, b = bh >> 3;
                const size_t row0 = (size_t)b * SEQ + c * 64;
                const int chn = h * 128 + k;
                const float l0 = p.lb_logits[chn], l1 = p.lb_logits[1024 + chn], l2 = p.lb_logits[2048 + chn];
                bf16_t fzr[16];
#pragma unroll
                for (int i = 0; i < 16; ++i) fzr[i] = BIG[(row0 + 16 * I + i) * INC + 3072 + chn];
                u32x4 vst[2];
#pragma unroll
                for (int i = 0; i < 2; ++i) { const int idx = tid + 512 * i, r = idx >> 4, ch = idx & 15; vst[i] = *(const u32x4*)(BIG + (row0 + r) * INC + 4096 + h * 128 + 8 * ch); }
                __builtin_amdgcn_sched_barrier(0);
                float lb; { const float mxl = fmaxf(l0, fmaxf(l1, l2)); const float e0 = __expf(l0 - mxl), e1 = __expf(l1 - mxl), e2 = __expf(l2 - mxl); lb = e0 / (e0 + e1 + e2); }
                float lf[16], kk[16]; float tot = 0.f;
#pragma unroll
                for (int i = 0; i < 16; ++i) { const float fz = bf2f(fzr[i]); const float sg = sigmoidf_(fz); lf[i] = __logf(lb + (1.0f - lb) * sg); kk[i] = (1.0f - lb) * __builtin_amdgcn_rcpf(1.0f + __expf(fz)); tot += lf[i]; }
                __syncthreads();
                EX[I * 128 + k] = tot;
#pragma unroll
                for (int i = 0; i < 2; ++i) { const int idx = tid + 512 * i, r = idx >> 4, ch = idx & 15; *(LAS u32x4*)(VS + (r * HP + 8 * ch) * 2) = vst[i]; }
                __syncthreads();
                float prefix = 0.f, total = 0.f;
#pragma unroll
                for (int ii = 0; ii < 4; ++ii) { const float e = EX[ii * 128 + k]; total += e; if (ii < I) prefix += e; }
                if (I == 0) DK[(size_t)unit * 128 + k] = __expf(total);
                float bc = prefix;
#pragma unroll
                for (int i = 0; i < 16; ++i) { bc += lf[i]; const float kt = kk[i] * __expf(total - bc); *(LAS bf16_t*)(KT + ((16 * I + i) * HP + k) * 2) = (bf16_t)(pk2(kt, 0.f) & 0xffffu); }
                __syncthreads();
                const unsigned KTa = lds_addr_of(KT), VSa = lds_addr_of(VS);
                f32x4 acc[8];
#pragma unroll
                for (int vt = 0; vt < 8; ++vt) acc[vt] = (f32x4){0.f, 0.f, 0.f, 0.f};
#pragma unroll
                for (int k2 = 0; k2 < 2; ++k2) {
                    const bf16x8 a = tr_frag(KTa, 32 * k2, 16 * wave, lane);
                    const unsigned vb = VSa + (unsigned)(((32 * k2 + 8 * fq + (fr >> 2)) * HP + 4 * (fr & 3)) * 2);
                    s16x4 ra[8], rb[8];
                    TR8B(ra, vb, 0); TR8B(rb, vb, 128);
#pragma unroll
                    for (int vt = 0; vt < 4; ++vt) acc[vt] = __builtin_amdgcn_mfma_f32_16x16x32_bf16(a, cat8(ra[2 * vt], ra[2 * vt + 1]), acc[vt], 0, 0, 0);
#pragma unroll
                    for (int vt = 0; vt < 4; ++vt) acc[4 + vt] = __builtin_amdgcn_mfma_f32_16x16x32_bf16(a, cat8(rb[2 * vt], rb[2 * vt + 1]), acc[4 + vt], 0, 0, 0);
                }
#pragma unroll
                for (int vt = 0; vt < 8; ++vt) { u32x2 w; w.x = pk2(acc[vt][0], acc[vt][1]); w.y = pk2(acc[vt][2], acc[vt][3]);
                    *(u32x2*)(SSTB + ((size_t)unit * 128 + 16 * vt + fr) * 128 + 16 * wave + 4 * fq) = w; }
            }
            __syncthreads();
        }
    PHASE_END

    PHASE_BEGIN
        {
            pg8::Gemm g{XN, WG, 1024, 256, 256, (size_t)256 * 2, (size_t)512 * 256 * 2}; pg8::Order S; S.init(NTOK, 512, 4, G, bid);
            pg8::EpiGates E{XN, p.b_a, p.b_i, SPT, LAU};
            pg8::gemm_phase(lds, g, S, E, tid);
        }
        int lane2; asm volatile("v_mbcnt_lo_u32_b32 %0, -1, 0\n\tv_mbcnt_hi_u32_b32 %0, -1, %0" : "=v"(lane2));
        {
            pg8::Order S; S.init(NTOK, 512, 4, G, bid); pg8::Unit uu;
            const int tid2 = wave * 64 + lane2, half = tid2 >> 8, sub = (tid2 >> 7) & 1, chl = tid2 & 127;
            for (int i = 0; S.next(i, uu); ++i) {
                const int ch = uu.z * 256 + uu.pn * 128 + chl, cidx = 2 * uu.pm + half;
                const unsigned* src = LAU + ((size_t)cidx * 128 + 64 * sub) * 1024 + ch;
                float P = 1.f, H = 0.f;
#pragma unroll 16
                for (int t = 0; t < 64; ++t) { const unsigned w = src[(size_t)t * 1024]; const float a = __expf(bflo(w)); H = a * H + bfhi(w); P *= a; }
                LAS float* X2 = (LAS float*)lds;
                if (sub == 1) { X2[(half * 128 + chl) * 2] = P; X2[(half * 128 + chl) * 2 + 1] = H; }
                __syncthreads();
                if (sub == 0) { const float P1 = X2[(half * 128 + chl) * 2], H1 = X2[(half * 128 + chl) * 2 + 1]; AGG[(size_t)cidx * 1024 + ch] = (f32x2){P * P1, P1 * H + H1}; }
                __syncthreads();
            }
        }
        if (rep == 0) for (int gid = bid * 512 + wave * 64 + lane2; gid < 131072; gid += NGT) {
            const int bh = gid >> 13, e = gid & 8191, v = e >> 6, k2 = (e & 63) * 2;
            f32x2 s = {0.f, 0.f};
            unsigned* base = (unsigned*)(SSTB + ((size_t)bh * 128 * 128 + v) * 128 + k2);
            const float* dbase = DK + (size_t)bh * 128 * 128 + k2;
#pragma unroll 1
            for (int c0 = 0; c0 < 128; c0 += 8) {
                unsigned tw[8]; f32x2 dd[8];
#pragma unroll
                for (int u = 0; u < 8; ++u) { tw[u] = base[(size_t)(c0 + u) * 8192]; dd[u] = *(const f32x2*)(dbase + (size_t)(c0 + u) * 128); }
#pragma unroll
                for (int u = 0; u < 8; ++u) { base[(size_t)(c0 + u) * 8192] = pk2(s.x, s.y); s = dd[u] * s + (f32x2){bflo(tw[u]), bfhi(tw[u])}; }
            }
        }
    PHASE_END

    PHASE_BEGIN
        __syncthreads();
        {
            LAS unsigned char* QT = lds; LAS unsigned char* AI = lds + 17408; LAS unsigned char* VS = lds + 2 * 17408; LAS unsigned char* BI = lds + 3 * 17408;
            LAS unsigned char* SC = BI + 160 * HP * 2; LAS float* EX = (LAS float*)(SC + 8 * 2304); LAS float* SSQ = EX + 1024;
            const int k = tid & 127, I = tid >> 7;
            const int fr = lane & 15, fq = lane >> 4;
            const int wI = wave & 3, vh = wave >> 2;
            for (int unit = bid; unit < 2048; unit += G) {
                const int c = unit & 127, bh = unit >> 7, h = bh & 7, b = bh >> 3;
                const size_t row0 = (size_t)b * SEQ + c * 64;
                const int chn = h * 128 + k;
                const float l0 = p.lb_logits[chn], l1 = p.lb_logits[1024 + chn], l2 = p.lb_logits[2048 + chn];
                bf16_t fzr[16], qr[16];
#pragma unroll
                for (int i = 0; i < 16; ++i) { fzr[i] = BIG[(row0 + 16 * I + i) * INC + 3072 + chn]; qr[i] = BIG[(row0 + 16 * I + i) * INC + 2048 + chn]; }
                u32x4 vst[2];
#pragma unroll
                for (int i = 0; i < 2; ++i) { const int idx = tid + 512 * i, r = idx >> 4, ch = idx & 15; vst[i] = *(const u32x4*)(BIG + (row0 + r) * INC + 4096 + h * 128 + 8 * ch); }
                bf16x8 sin[4][4];
#pragma unroll
                for (int kq = 0; kq < 4; ++kq)
#pragma unroll
                    for (int vt = 0; vt < 4; ++vt) sin[kq][vt] = *(const bf16x8*)(SSTB + ((size_t)unit * 128 + 64 * vh + 16 * vt + fr) * 128 + 32 * kq + 8 * fq);
                const size_t orow = row0 + 16 * wI + fr;
                u32x2 graw[4]; f32x4 gnv[4];
#pragma unroll
                for (int vt = 0; vt < 4; ++vt) { const int v = 64 * vh + 16 * vt + 4 * fq; graw[vt] = *(const u32x2*)(BIG + orow * INC + 5120 + h * 128 + v); gnv[vt] = *(const f32x4*)(p.g_norm + h * 128 + v); }
                __builtin_amdgcn_sched_barrier(0);
                float lb; { const float mxl = fmaxf(l0, fmaxf(l1, l2)); const float e0 = __expf(l0 - mxl), e1 = __expf(l1 - mxl), e2 = __expf(l2 - mxl); lb = e0 / (e0 + e1 + e2); }
                float lf[16], kk[16]; float tot = 0.f;
#pragma unroll
                for (int i = 0; i < 16; ++i) { const float fz = bf2f(fzr[i]); const float sg = sigmoidf_(fz); lf[i] = __logf(lb + (1.0f - lb) * sg); kk[i] = (1.0f - lb) * __builtin_amdgcn_rcpf(1.0f + __expf(fz)); tot += lf[i]; }
                __syncthreads();
                EX[I * 128 + k] = tot; EX[512 + I * 128 + k] = lf[0];
#pragma unroll
                for (int i = 0; i < 2; ++i) { const int idx = tid + 512 * i, r = idx >> 4, ch = idx & 15; *(LAS u32x4*)(VS + (r * HP + 8 * ch) * 2) = vst[i]; }
                __syncthreads();
                float bref[4]; float prefix = 0.f;
                { float run = 0.f;
#pragma unroll
                  for (int ii = 0; ii < 4; ++ii) { bref[ii] = run + EX[512 + ii * 128 + k]; if (ii == I) prefix = run; run += EX[ii * 128 + k]; } }
                float brefI = bref[0];
#pragma unroll
                for (int ii = 1; ii < 4; ++ii) if (ii == I) brefI = bref[ii];
                float bc = prefix;
#pragma unroll
                for (int i = 0; i < 16; ++i) {
                    bc += lf[i];
                    const int t = 16 * I + i;
                    const float qs = siluf_(bf2f(qr[i]));
                    *(LAS bf16_t*)(QT + (t * HP + k) * 2) = (bf16_t)(pk2(qs * __expf(bc), 0.f) & 0xffffu);
                    *(LAS bf16_t*)(AI + (t * HP + k) * 2) = (bf16_t)(pk2(qs * __expf(bc - brefI), 0.f) & 0xffffu);
#pragma unroll
                    for (int ii = 0; ii < 4; ++ii) if (ii >= I) { const int offB = 8 * ii * (ii + 1); *(LAS bf16_t*)(BI + ((offB + t) * HP + k) * 2) = (bf16_t)(pk2(kk[i] * __expf(bref[ii] - bc), 0.f) & 0xffffu); }
                }
                __syncthreads();
                LAS unsigned char* SCw = SC + wave * 2304;
                const int offBI = 8 * wI * (wI + 1);
#pragma unroll
                for (int J = 0; J < 4; ++J) {
                    u32x2 w = {0u, 0u};
                    if (J <= wI) {
                        f32x4 sacc = {0.f, 0.f, 0.f, 0.f};
#pragma unroll
                        for (int kq = 0; kq < 4; ++kq) {
                            const bf16x8 a = *(const LAS bf16x8*)(BI + ((offBI + 16 * J + fr) * HP + 32 * kq + 8 * fq) * 2);
                            const bf16x8 bq = *(const LAS bf16x8*)(AI + ((16 * wI + fr) * HP + 32 * kq + 8 * fq) * 2);
                            sacc = __builtin_amdgcn_mfma_f32_16x16x32_bf16(a, bq, sacc, 0, 0, 0);
                        }
#pragma unroll
                        for (int j = 0; j < 4; ++j) if (16 * J + 4 * fq + j > 16 * wI + fr) sacc[j] = 0.f;
                        w.x = pk2(sacc[0], sacc[1]); w.y = pk2(sacc[2], sacc[3]);
                    }
                    *(LAS u32x2*)(SCw + (fr * 72 + 16 * J + 4 * fq) * 2) = w;
                }
                lds_wait();
                f32x4 o[4];
#pragma unroll
                for (int vt = 0; vt < 4; ++vt) o[vt] = (f32x4){0.f, 0.f, 0.f, 0.f};
#pragma unroll
                for (int kq = 0; kq < 4; ++kq) {
                    const bf16x8 bq = *(const LAS bf16x8*)(QT + ((16 * wI + fr) * HP + 32 * kq + 8 * fq) * 2);
#pragma unroll
                    for (int vt = 0; vt < 4; ++vt) o[vt] = __builtin_amdgcn_mfma_f32_16x16x32_bf16(sin[kq][vt], bq, o[vt], 0, 0, 0);
                }
                const unsigned VSa = lds_addr_of(VS);
#pragma unroll
                for (int k2 = 0; k2 < 2; ++k2) {
                    const bf16x8 bs = *(const LAS bf16x8*)(SCw + (fr * 72 + 32 * k2 + 8 * fq) * 2);
                    const unsigned vb = VSa + (unsigned)(((32 * k2 + 8 * fq + (fr >> 2)) * HP + 64 * vh + 4 * (fr & 3)) * 2);
                    s16x4 ra[8];
                    TR8B(ra, vb, 0);
#pragma unroll
                    for (int vt = 0; vt < 4; ++vt) o[vt] = __builtin_amdgcn_mfma_f32_16x16x32_bf16(cat8(ra[2 * vt], ra[2 * vt + 1]), bs, o[vt], 0, 0, 0);
                }
                float ssq = 0.f;
#pragma unroll
                for (int vt = 0; vt < 4; ++vt) ssq += (o[vt][0] * o[vt][0] + o[vt][1] * o[vt][1]) + (o[vt][2] * o[vt][2] + o[vt][3] * o[vt][3]);
                ssq += __shfl_xor(ssq, 16); ssq += __shfl_xor(ssq, 32);
                if (fq == 0) SSQ[vh * 64 + 16 * wI + fr] = ssq;
                __syncthreads();
                const float rstd = 1.0f / sqrtf((SSQ[16 * wI + fr] + SSQ[64 + 16 * wI + fr]) * (1.0f / 128.0f) + 1e-6f);
#pragma unroll
                for (int vt = 0; vt < 4; ++vt) {
                    const int v = 64 * vh + 16 * vt + 4 * fq;
                    const float g0 = siluf_(bflo(graw[vt].x)), g1 = siluf_(bfhi(graw[vt].x)), g2 = siluf_(bflo(graw[vt].y)), g3 = siluf_(bfhi(graw[vt].y));
                    u32x2 w; w.x = pk2(o[vt][0] * rstd * gnv[vt][0] * g0, o[vt][1] * rstd * gnv[vt][1] * g1); w.y = pk2(o[vt][2] * rstd * gnv[vt][2] * g2, o[vt][3] * rstd * gnv[vt][3] * g3);
                    *(u32x2*)(XN + orow * DM + 1024 + h * 128 + v) = w;
                }
            }
            __syncthreads();
        }
        int lane4; asm volatile("v_mbcnt_lo_u32_b32 %0, -1, 0\n\tv_mbcnt_hi_u32_b32 %0, -1, %0" : "=v"(lane4));
        const int gt4 = bid * 512 + wave * 64 + lane4;
        for (int gid = gt4; gid < 131072; gid += NGT) {
            const int ch = gid & 1023, cidx = gid >> 10, chunk = cidx & 63, b = cidx >> 6;
            float hst = 0.f;
#pragma unroll 1
            for (int cc0 = 0; cc0 < chunk; cc0 += 8) {
                f32x2 ag[8];
#pragma unroll
                for (int u = 0; u < 8; ++u) { const int cc = (cc0 + u < 63) ? cc0 + u : 63; ag[u] = AGG[(b * 64 + cc) * 1024 + ch]; }
#pragma unroll
                for (int u = 0; u < 8; ++u) if (cc0 + u < chunk) hst = ag[u].x * hst + ag[u].y;
            }
            const unsigned* src = LAU + (size_t)cidx * 128 * 1024 + ch;
            const size_t trow = (size_t)cidx * 128;
#pragma unroll 1
            for (int t0 = 0; t0 < 128; t0 += 16) {
                unsigned w[16]; bf16_t yv[16];
#pragma unroll
                for (int u = 0; u < 16; ++u) { w[u] = src[(size_t)(t0 + u) * 1024]; yv[u] = BIG[(trow + t0 + u) * INC + 1024 + ch]; }
#pragma unroll
                for (int u = 0; u < 16; ++u) {
                    hst = __expf(bflo(w[u])) * hst + bfhi(w[u]);
                    XN[(trow + t0 + u) * DM + ch] = (bf16_t)(pk2(hst * gelu_tanh(bf2f(yv[u])), 0.f) & 0xffffu);
                }
            }
        }
        transpose_job(p.w_qkv, DM, INC, WA, -1, p.norm_mix + DM, lds, gw, NGW, wave, lane4);
        for (int idx = gt4; idx < NTOK * 16; idx += NGT) {
            const int row = idx >> 4, i = idx & 15;
            const float invf = exp2f(-(float)i * (18.931568569324174f / 16.0f));
            const float ang = (float)p.pos[row] * invf;
            const double rev = (double)ang * 0.15915494309189535;
            const float fr_ = (float)(rev - __builtin_rint(rev));
            TAB[(size_t)idx * 2] = __builtin_amdgcn_cosf(fr_); TAB[(size_t)idx * 2 + 1] = __builtin_amdgcn_sinf(fr_);
        }
    PHASE_END

    PHASE_BEGIN
        pg8::Gemm g{XN, WB, DM, DM, DM, 0, 0}; pg8::Order S; S.init(NTOK, DM, 1, G, bid);
        pg8::EpiResidB<true> E{p.x, nullptr, HB, SSQP};
        pg8::gemm_phase(lds, g, S, E, tid);
    PHASE_END

    PHASE_BEGIN
        pg8::Gemm g{HB, W1, DM, DM, DM, 0, 0}; pg8::Order S; S.init(NTOK, DFF, 1, G, bid);
        fill_rstd_table(RT, SSQP, S, tid);
        pg8::EpiBf16<1, true> E{BIG, DFF, RT};
        pg8::gemm_phase(lds, g, S, E, tid);
    PHASE_END

    PHASE_BEGIN
        pg8::Gemm g{BIG, W2, DFF, DFF, DFF, 0, 0}; pg8::Order S; S.init(NTOK, DM, 1, G, bid);
        pg8::EpiResidB<false> E{nullptr, HB, HB, SSQP};
        pg8::gemm_phase(lds, g, S, E, tid);
    PHASE_END

    PHASE_BEGIN
        pg8::Gemm g{HB, WA, DM, DM, DM, 0, 0}; pg8::Order S; S.init(NTOK, INC, 1, G, bid);
        fill_rstd_table(RT, SSQP, S, tid);
        pg8::EpiQkv E{BIG, TAB, RT};
        pg8::gemm_phase(lds, g, S, E, tid);
    PHASE_END

    PHASE_BEGIN
        LAS unsigned char* KS = lds + wave * (2 * 32 * HP * 2); LAS unsigned char* VS = KS + 32 * HP * 2;
        for (int it = 0; it * G < 1024; ++it) {
            const int item = (G == 256) ? ((bid & 7) * 128 + it * 32 + (bid >> 3)) : (bid + it * G);
            if (item >= 1024) break;
            const int b = item >> 9, h = (item >> 5) & 15, n = item & 31;
            const int r0 = wave, r1 = wave + 8;
            QTile t0, t1;
            const int fr_ = lane & 15;
            {
                const int pc0 = 32 * wave + fr_, pc1 = pc0 + 16;
                attn_tile_init(t0, BIG, b, h, n, 0, lane); attn_tile_init(t1, BIG, b, h, n, 0, lane);
                attn_q_load(t0, BIG, (size_t)b * SEQ + 256 * n + pc0, h, lane); attn_q_load(t1, BIG, (size_t)b * SEQ + 256 * n + pc1, h, lane);
                int g = 0;
                while (g < 12 && 256 * n - 128 + 32 * g + 31 < 0) ++g;
                const int kidx = tid >> 4, ch = tid & 15;
                u32x4 rk, rv;
                { int mk = 256 * n - 128 + 32 * g + kidx; mk = mk < 0 ? 0 : mk; const size_t row = (size_t)b * SEQ + mk;
                  rk = *(const u32x4*)(BIG + row * INC + 2048 + h * 128 + 8 * ch); rv = *(const u32x4*)(BIG + row * INC + 4096 + h * 128 + 8 * ch); }
                __syncthreads();
                int buf = 0;
#pragma unroll 1
                for (; g < 12; ++g) {
                    const int mk0 = 256 * n - 128 + 32 * g;
                    LAS unsigned char* SK = lds + buf * 17408; LAS unsigned char* SV = SK + 8704;
                    *(LAS u32x4*)(SK + (kidx * HP + 8 * ch) * 2) = rk; *(LAS u32x4*)(SV + (kidx * HP + 8 * ch) * 2) = rv;
                    __syncthreads();
                    if (g + 1 < 12) { const size_t row = (size_t)b * SEQ + (mk0 + 32 + kidx);
                        rk = *(const u32x4*)(BIG + row * INC + 2048 + h * 128 + 8 * ch); rv = *(const u32x4*)(BIG + row * INC + 4096 + h * 128 + 8 * ch); }
                    if (g >= wave && g <= wave + 4) attn_pair_update(t0, 256 * n + pc0, t1, 256 * n + pc1, mk0, lds_addr_of(SV), SK, lane);
                    buf ^= 1;
                }
                __syncthreads();
                attn_dump(t0, lds, pc0, lane); attn_dump(t1, lds, pc1, lane);
                __syncthreads();
                attn_pick(t0, lds, 16 * fr_ + r0, lane); attn_pick(t1, lds, 16 * fr_ + r1, lane);
                attn_q_load(t0, BIG, (size_t)b * SEQ + 256 * n + 16 * fr_ + r0, h, lane); attn_q_load(t1, BIG, (size_t)b * SEQ + 256 * n + 16 * fr_ + r1, h, lane);
                __syncthreads();
            }
            attn_branch<true, true>(BIG, b, h, n, 2, wave & 3, 64 * n - 128, 6, t0, r0, t1, r1, KS, VS, lane);
            attn_branch<true, false>(BIG, b, h, n, 4, r0, 16 * n - 144, 5, t0, r0, t1, r1, KS, VS, lane);
            attn_branch<false, true>(BIG, b, h, n, 4, r1, 16 * n - 144, 5, t0, r0, t1, r1, KS, VS, lane);
            attn_tile_store(t0, XN, b, h, n, r0, lane); attn_tile_store(t1, XN, b, h, n, r1, lane);
        }
        __syncthreads();
        int lane3; asm volatile("v_mbcnt_lo_u32_b32 %0, -1, 0\n\tv_mbcnt_hi_u32_b32 %0, -1, %0" : "=v"(lane3));
        transpose_job(p.w_o, DM, DM, WB, -1, nullptr, lds, gw, NGW, wave, lane3);
        transpose_job(p.w1 + (size_t)DM * DFF, DM, DFF, W1, -1, p.norm_mlp + DM, lds, gw, NGW, wave, lane3);
        transpose_job(p.w2 + (size_t)DM * DFF, DFF, DM, W2, -1, nullptr, lds, gw, NGW, wave, lane3);
    PHASE_END

    PHASE_BEGIN
        pg8::Gemm g{XN, WB, DM, DM, DM, 0, 0}; pg8::Order S; S.init(NTOK, DM, 1, G, bid);
        pg8::EpiResidB<false> E{nullptr, HB, HB, SSQP};
        pg8::gemm_phase(lds, g, S, E, tid);
    PHASE_END

    PHASE_BEGIN
        pg8::Gemm g{HB, W1, DM, DM, DM, 0, 0}; pg8::Order S; S.init(NTOK, DFF, 1, G, bid);
        fill_rstd_table(RT, SSQP, S, tid);
        pg8::EpiBf16<1, true> E{BIG, DFF, RT};
        pg8::gemm_phase(lds, g, S, E, tid);
    PHASE_END

    PHASE_BEGIN
        pg8::Gemm g{BIG, W2, DFF, DFF, DFF, 0, 0}; pg8::Order S; S.init(NTOK, DM, 1, G, bid);
        pg8::EpiResidB<false> E{nullptr, HB, HB, nullptr};
        pg8::gemm_phase(lds, g, S, E, tid);
    PHASE_END

    PHASE_BEGIN
        norm_rows_from_bf16<true>(HB, p.final_norm, nullptr, p.out, gw, NGW, lane);
    PHASE_END
#undef PHASE_BEGIN
#undef PHASE_END
}
constexpr int N_PHASES = 14;

extern "C" void kernel_launch(void* const* d_in, const int* in_sizes, int n_in, void* d_out, int out_size, void* d_ws, size_t ws_size, hipStream_t stream) {
    static int grid = 0;
    if (grid == 0) {
        if (n_in != 20 || ws_size < WS_END) { fprintf(stderr, "kernel_launch: unexpected n_in %d / ws_size %zu\n", n_in, ws_size); grid = -1; return; }
        int dev = 0, cus = 0, per_cu = 0;
        hipGetDevice(&dev);
        hipDeviceGetAttribute(&cus, hipDeviceAttributeMultiprocessorCount, dev);
        if (hipFuncSetAttribute((const void*)mega, hipFuncAttributeMaxDynamicSharedMemorySize, LDS_BYTES) != hipSuccess) { fprintf(stderr, "kernel_launch: hipFuncSetAttribute failed\n"); grid = -1; return; }
        if (hipOccupancyMaxActiveBlocksPerMultiprocessor(&per_cu, (const void*)mega, 512, LDS_BYTES) != hipSuccess || per_cu < 1) { fprintf(stderr, "kernel_launch: occupancy query says %d\n", per_cu); per_cu = 1; }
        (void)hipGetLastError();
        grid = cus * 1;
    }
    if (grid < 0) return;
    Params p{};
    p.x = (const float*)d_in[0]; p.pos = (const int*)d_in[1]; p.norm_mix = (const float*)d_in[2]; p.norm_mlp = (const float*)d_in[3]; p.final_norm = (const float*)d_in[4];
    p.w_in = (const float*)d_in[5]; p.conv_w = (const float*)d_in[6]; p.conv_b = (const float*)d_in[7]; p.w_a = (const float*)d_in[8]; p.b_a = (const float*)d_in[9];
    p.w_i = (const float*)d_in[10]; p.b_i = (const float*)d_in[11]; p.lam = (const float*)d_in[12]; p.lb_logits = (const float*)d_in[13]; p.g_norm = (const float*)d_in[14];
    p.w_out = (const float*)d_in[15]; p.w_qkv = (const float*)d_in[16]; p.w_o = (const float*)d_in[17]; p.w1 = (const float*)d_in[18]; p.w2 = (const float*)d_in[19];
    p.out = (float*)d_out; p.ws = (unsigned char*)d_ws;
    int lo = 0, hi = N_PHASES;
    void* args[] = {&p, &lo, &hi};
    hipError_t e = hipLaunchCooperativeKernel((const void*)mega, dim3(grid), dim3(512), args, LDS_BYTES, stream);
    if (e != hipSuccess) fprintf(stderr, "kernel_launch: cooperative launch failed: %s (grid %d)\n", hipGetErrorString(e), grid);
}
```

```cpp
#include <hip/hip_runtime.h>
#include <hip/hip_cooperative_groups.h>
#include <cstdio>
namespace cg = cooperative_groups;

#define LAS __attribute__((address_space(3)))
typedef unsigned short bf16_t;
typedef short bf16x8 __attribute__((ext_vector_type(8)));
typedef short s16x4 __attribute__((ext_vector_type(4)));
typedef float f32x4 __attribute__((ext_vector_type(4)));
typedef float f32x2 __attribute__((ext_vector_type(2)));
typedef unsigned u32x4 __attribute__((ext_vector_type(4)));
typedef unsigned u32x2 __attribute__((ext_vector_type(2)));

constexpr int SEQ = 8192, NTOK = 16384, DM = 2048, DFF = 8192, INC = 6144;
constexpr int LDS_BYTES = 144 * 1024;
constexpr size_t MiB = 1024 * 1024;
constexpr size_t WS_WA = 0, WS_WB = 24 * MiB, WS_W1 = 32 * MiB, WS_W2 = 64 * MiB, WS_WG = 96 * MiB;
constexpr size_t WS_AGG = 97 * MiB, WS_DK = 98 * MiB, WS_CTR = 99 * MiB, WS_TAB = 100 * MiB;
constexpr size_t WS_XN = 104 * MiB, WS_BIG = 168 * MiB, WS_LA = WS_BIG + 192 * MiB, WS_LU = 424 * MiB, WS_END = 488 * MiB;

struct Params {
    const float* x; const int* pos; const float* norm_mix; const float* norm_mlp; const float* final_norm;
    const float* w_in; const float* conv_w; const float* conv_b; const float* w_a; const float* b_a; const float* w_i; const float* b_i;
    const float* lam; const float* lb_logits; const float* g_norm; const float* w_out; const float* w_qkv; const float* w_o; const float* w1; const float* w2;
    float* out; unsigned char* ws;
};

typedef __bf16 bf16v2_t __attribute__((ext_vector_type(2)));
__device__ __forceinline__ unsigned pk2(float lo, float hi) { bf16v2_t v; v[0] = (__bf16)lo; v[1] = (__bf16)hi; return __builtin_bit_cast(unsigned, v); }
__device__ __forceinline__ float bf2f(bf16_t b) { return __uint_as_float(((unsigned)b) << 16); }
__device__ __forceinline__ float bflo(unsigned w) { return __uint_as_float(w << 16); }
__device__ __forceinline__ float bfhi(unsigned w) { return __uint_as_float(w & 0xffff0000u); }
__device__ __forceinline__ float sigmoidf_(float x) { return __builtin_amdgcn_rcpf(1.0f + __expf(-x)); }
__device__ __forceinline__ float siluf_(float x) { return x * __builtin_amdgcn_rcpf(1.0f + __expf(-x)); }
__device__ __forceinline__ float gelu_tanh(float y) { const float z = 0.7978845608028654f * (y + 0.044715f * y * y * y); const float t = 1.0f - 2.0f / (__expf(2.0f * z) + 1.0f); return 0.5f * y * (1.0f + t); }
__device__ __forceinline__ float wave_sum(float v) {
#pragma unroll
    for (int o = 1; o < 64; o <<= 1) v += __shfl_xor(v, o);
    return v;
}
__device__ __forceinline__ void lds_wait() { asm volatile("s_waitcnt lgkmcnt(0)" ::: "memory"); }
__device__ __forceinline__ s16x4 tr_read(unsigned lds_addr) { s16x4 r; asm volatile("ds_read_b64_tr_b16 %0, %1\n\ts_waitcnt lgkmcnt(0)" : "=&v"(r) : "v"(lds_addr) : "memory"); return r; }
__device__ __forceinline__ bf16x8 cat8(s16x4 a, s16x4 b) { bf16x8 r; r[0] = a[0]; r[1] = a[1]; r[2] = a[2]; r[3] = a[3]; r[4] = b[0]; r[5] = b[1]; r[6] = b[2]; r[7] = b[3]; return r; }
__device__ __forceinline__ bf16x8 pack8(f32x4 a, f32x4 b) { u32x4 w; w.x = pk2(a[0], a[1]); w.y = pk2(a[2], a[3]); w.z = pk2(b[0], b[1]); w.w = pk2(b[2], b[3]); return __builtin_bit_cast(bf16x8, w); }
__device__ __forceinline__ unsigned lds_addr_of(LAS unsigned char* p) { return (unsigned)(size_t)p; }

namespace pg8 {
constexpr int BM = 256, BK = 64, HALF = 128, HTB = HALF * BK * 2, STAGE_BYTES = 8 * HTB, NXCD = 8, WGM = 4;
__device__ __forceinline__ int lds_byte(int r, int c) { const int st = (r >> 4) * 2 + (c >> 5), rr = r & 15, cc = c & 31, ob = rr * 64 + cc * 2; return st * 1024 + (ob ^ (((ob >> 9) & 1) << 5)); }
__device__ __forceinline__ void stage_rc(int b, int& R, int& C) { const int st = b / 1024, sb = b % 1024, swz = sb ^ (((sb >> 9) & 1) << 5); R = (st >> 1) * 16 + swz / 64; C = (st & 1) * 32 + (swz % 64) / 2; }
__device__ __forceinline__ int perm32(int rho) { const int n = rho >> 4, i = rho & 15; return 8 * (i >> 2) + 4 * n + (i & 3); }

struct Unit { int pm, pn, z, i; };
struct Gemm { const bf16_t* A; const bf16_t* Bt; int lda, ldb, K; size_t a_z, b_z; };
struct Order {
    int nM, nN, nZ, per, G, c;
    __device__ void init(int M, int N, int Z, int G_, int c_) { nM = M / BM; nN = N / BM; nZ = Z; per = nM * nN; G = G_; c = c_; }
    __device__ bool next(int i, Unit& u) const {
        const long L = (long)i * G + c; if (L >= (long)per * nZ) return false;
        const int nwg = per * nZ;
        int wgid = (int)L; { const int q = nwg / NXCD, r = nwg % NXCD, xcd = wgid % NXCD, off = wgid / NXCD; wgid = (xcd < r ? xcd * (q + 1) : r * (q + 1) + (xcd - r) * q) + off; }
        u.z = wgid / per; wgid -= u.z * per;
        const int nig = WGM * nN, gid = wgid / nig, fm = gid * WGM, gsz = (nM - fm) < WGM ? (nM - fm) : WGM;
        u.pm = fm + ((wgid % nig) % gsz); u.pn = (wgid % nig) / gsz; u.i = i; return true;
    }
};

template <class Epi>
__device__ __forceinline__ void gemm_phase(LAS unsigned char* lds, const Gemm g, const Order& S, const Epi& E, const int tid) {
    const int wid = __builtin_amdgcn_readfirstlane(tid >> 6), lane = tid & 63, wr = wid >> 2, wc = wid & 3, fr = lane & 15, fq = lane >> 4;
    const int K = g.K, nt = K / BK;
    unsigned voffA[2], voffB[2];
#pragma unroll
    for (int i = 0; i < 2; ++i) { int R, C; stage_rc(tid * 16 + i * 8192, R, C); const int Rb = Epi::PERM ? ((R & ~31) + perm32(R & 31)) : R;
        voffA[i] = (unsigned)(R * g.lda + C) * 2u; voffB[i] = (unsigned)(Rb * g.ldb + C) * 2u; }
    const size_t kstep = (size_t)(BK * 2);
    const size_t hstepA = (size_t)HALF * g.lda * 2, hstepB = (size_t)HALF * g.ldb * 2;
    const size_t tstepA = 2 * hstepA, tstepB = 2 * hstepB;
    const unsigned ldsw = (unsigned)wid * 1024u;
    const int aoff = lds_byte(wr * 64 + fr, fq * 8), boff = lds_byte(wc * 32 + fr, fq * 8);
#define PG8_SA(b, h) (((b) * 2 + (h)) * HTB)
#define PG8_SB(b, h) ((4 + (b) * 2 + (h)) * HTB)
#define PG8_STAGE(bufoff, gbase, voff) do { _Pragma("unroll") for (int _i = 0; _i < 2; ++_i) \
        __builtin_amdgcn_global_load_lds((const unsigned*)((const char*)(gbase) + (voff)[_i]), (LAS unsigned*)(lds + (bufoff) + ldsw + _i * 8192), 16, 0, 0); } while (0)
#define PG8_LDA(dst, b, h) do { _Pragma("unroll") for (int m = 0; m < 4; ++m) _Pragma("unroll") for (int k = 0; k < 2; ++k) dst[m][k] = *(const LAS bf16x8*)(lds + PG8_SA(b, h) + aoff + m * 2048 + k * 1024); } while (0)
#define PG8_LDB(dst, b, h) do { _Pragma("unroll") for (int n = 0; n < 2; ++n) _Pragma("unroll") for (int k = 0; k < 2; ++k) dst[n][k] = *(const LAS bf16x8*)(lds + PG8_SB(b, h) + boff + n * 2048 + k * 1024); } while (0)
#define PG8_MMA(ai, bj, At, Bt) do { __builtin_amdgcn_s_setprio(1); _Pragma("unroll") for (int m = 0; m < 4; ++m) _Pragma("unroll") for (int n = 0; n < 2; ++n) _Pragma("unroll") for (int k = 0; k < 2; ++k) \
        acc[ai][bj][m][n] = __builtin_amdgcn_mfma_f32_16x16x32_bf16(Bt[n][k], At[m][k], acc[ai][bj][m][n], 0, 0, 0); __builtin_amdgcn_s_setprio(0); } while (0)
#define PG8_WAIT_V(n) asm volatile("s_waitcnt vmcnt(" #n ")" ::: "memory")
#define PG8_WAIT_L(n) asm volatile("s_waitcnt lgkmcnt(" #n ")" ::: "memory")
#define PG8_BAR __builtin_amdgcn_s_barrier()
#define PG8_SCHED __builtin_amdgcn_sched_barrier(0)
    Unit cur, nxt; int ui = 0;
    if (!S.next(0, cur)) return;
    f32x4 acc[2][2][4][2];
#pragma unroll
    for (int a = 0; a < 2; ++a)
#pragma unroll
        for (int b = 0; b < 2; ++b)
#pragma unroll
            for (int m = 0; m < 4; ++m)
#pragma unroll
                for (int n = 0; n < 2; ++n) acc[a][b][m][n] = (f32x4){0.f, 0.f, 0.f, 0.f};
    bf16x8 At[4][2], B0[2][2], B1[2][2];
    const char* cA = (const char*)g.A + (size_t)cur.pm * tstepA + (size_t)cur.z * g.a_z; const char* cB = (const char*)g.Bt + (size_t)cur.pn * tstepB + (size_t)cur.z * g.b_z;
    PG8_STAGE(PG8_SB(0, 0), cB, voffB); PG8_STAGE(PG8_SA(0, 0), cA, voffA); PG8_STAGE(PG8_SB(0, 1), cB + hstepB, voffB); PG8_STAGE(PG8_SA(0, 1), cA + hstepA, voffA);
    if (wr == 1) PG8_BAR;
    PG8_WAIT_V(4); PG8_BAR;
    PG8_STAGE(PG8_SB(1, 0), cB + kstep, voffB); PG8_STAGE(PG8_SA(1, 0), cA + kstep, voffA); PG8_STAGE(PG8_SB(1, 1), cB + hstepB + kstep, voffB);
    PG8_WAIT_V(6); PG8_BAR;
    for (;;) {
        const bool has_next = S.next(ui + 1, nxt);
        const char* nA = has_next ? (const char*)g.A + (size_t)nxt.pm * tstepA + (size_t)nxt.z * g.a_z : cA; const char* nB = has_next ? (const char*)g.Bt + (size_t)nxt.pn * tstepB + (size_t)nxt.z * g.b_z : cB;
        for (int t = 0; t < nt; t += 2) {
            const bool last = (t == nt - 2);
            const char* a1 = cA + (size_t)(t + 1) * kstep;
            const char* a2 = last ? nA : cA + (size_t)(t + 2) * kstep; const char* b2 = last ? nB : cB + (size_t)(t + 2) * kstep;
            const char* a3 = a2 + kstep; const char* b3 = b2 + kstep;
            PG8_LDB(B0, 0, 0); PG8_SCHED; PG8_LDA(At, 0, 0); PG8_STAGE(PG8_SA(1, 1), a1 + hstepA, voffA);
            PG8_WAIT_L(8); PG8_BAR; PG8_WAIT_L(0); PG8_MMA(0, 0, At, B0); PG8_BAR; PG8_SCHED;
            PG8_LDB(B1, 0, 1); PG8_STAGE(PG8_SB(0, 0), b2, voffB);
            PG8_BAR; PG8_WAIT_L(0); PG8_MMA(0, 1, At, B1); PG8_BAR;
            PG8_LDA(At, 0, 1); PG8_STAGE(PG8_SA(0, 0), a2, voffA);
            PG8_BAR; PG8_WAIT_L(0); PG8_MMA(1, 0, At, B0); PG8_BAR; PG8_SCHED;
            PG8_STAGE(PG8_SB(0, 1), b2 + hstepB, voffB);
            PG8_WAIT_V(6); PG8_BAR; PG8_MMA(1, 1, At, B1); PG8_BAR;
            PG8_LDB(B0, 1, 0); PG8_SCHED; PG8_LDA(At, 1, 0); PG8_STAGE(PG8_SA(0, 1), a2 + hstepA, voffA);
            PG8_WAIT_L(8); PG8_BAR; PG8_WAIT_L(0); PG8_MMA(0, 0, At, B0); PG8_BAR; PG8_SCHED;
            PG8_LDB(B1, 1, 1); PG8_STAGE(PG8_SB(1, 0), b3, voffB);
            PG8_BAR; PG8_WAIT_L(0); PG8_MMA(0, 1, At, B1); PG8_BAR;
            PG8_LDA(At, 1, 1); PG8_STAGE(PG8_SA(1, 0), a3, voffA);
            PG8_BAR; PG8_WAIT_L(0); PG8_MMA(1, 0, At, B0); PG8_BAR; PG8_SCHED;
            PG8_STAGE(PG8_SB(1, 1), b3 + hstepB, voffB);
            PG8_WAIT_V(6); PG8_BAR; PG8_MMA(1, 1, At, B1); PG8_BAR;
        }
        E(acc, cur, wr, wc, fr, fq);
        if (!has_next) break;
#pragma unroll
        for (int a = 0; a < 2; ++a)
#pragma unroll
            for (int b = 0; b < 2; ++b)
#pragma unroll
                for (int m = 0; m < 4; ++m)
#pragma unroll
                    for (int n = 0; n < 2; ++n) acc[a][b][m][n] = (f32x4){0.f, 0.f, 0.f, 0.f};
        cur = nxt; cA = nA; cB = nB; ++ui;
    }
    PG8_WAIT_V(0);
    if (wr == 0) PG8_BAR;
    PG8_BAR;
#undef PG8_SA
#undef PG8_SB
#undef PG8_STAGE
#undef PG8_LDA
#undef PG8_LDB
#undef PG8_MMA
#undef PG8_WAIT_V
#undef PG8_WAIT_L
#undef PG8_BAR
#undef PG8_SCHED
}

template <int ACT  , bool RS = false> struct EpiBf16 {
    static constexpr bool PERM = true;
    bf16_t* O; int ldc; const LAS float* rt;
    __device__ __forceinline__ void operator()(const f32x4 (&acc)[2][2][4][2], const Unit& u, int wr, int wc, int fr, int fq) const {
        const int row0 = u.pm * BM + wr * 64 + fr, col0 = u.pn * BM + wc * 32 + 8 * fq;
#pragma unroll
        for (int ai = 0; ai < 2; ++ai)
#pragma unroll
            for (int m = 0; m < 4; ++m) { bf16_t* rowp = O + (size_t)(row0 + ai * HALF + m * 16) * ldc + col0;
                float rs = 1.0f; if (RS) rs = rt[u.i * 256 + wr * 64 + fr + ai * HALF + m * 16];
#pragma unroll
                for (int bj = 0; bj < 2; ++bj) { f32x4 v0 = acc[ai][bj][m][0], v1 = acc[ai][bj][m][1];
                    if (RS) { v0 *= rs; v1 *= rs; }
                    if (ACT == 1) {
#pragma unroll
                        for (int j = 0; j < 4; ++j) { const float a = fmaxf(v0[j], 0.f), b = fmaxf(v1[j], 0.f); v0[j] = a * a; v1[j] = b * b; } }
                    u32x4 w; w.x = pk2(v0[0], v0[1]); w.y = pk2(v0[2], v0[3]); w.z = pk2(v1[0], v1[1]); w.w = pk2(v1[2], v1[3]);
                    *(u32x4*)(rowp + bj * HALF) = w; } }
    }
};
template <bool BASE_F32> struct EpiResidB {
    static constexpr bool PERM = true;
    const float* basef; const bf16_t* baseb; bf16_t* out; float* ssqp;
    __device__ __forceinline__ void operator()(const f32x4 (&acc)[2][2][4][2], const Unit& u, int wr, int wc, int fr, int fq) const {
        const int row0 = u.pm * BM + wr * 64 + fr, col0 = u.pn * BM + wc * 32 + 8 * fq;
#pragma unroll
        for (int ai = 0; ai < 2; ++ai) {
            if (BASE_F32) {
#pragma unroll
                for (int m = 0; m < 4; m += 2) {
                    f32x4 bs[2][2][2];
#pragma unroll
                    for (int mm = 0; mm < 2; ++mm) { const size_t off = (size_t)(row0 + ai * HALF + (m + mm) * 16) * DM + col0;
#pragma unroll
                        for (int bj = 0; bj < 2; ++bj)
#pragma unroll
                            for (int n = 0; n < 2; ++n) bs[mm][bj][n] = *(const f32x4*)(basef + off + bj * HALF + n * 4); }
#pragma unroll
                    for (int mm = 0; mm < 2; ++mm) { const size_t off = (size_t)(row0 + ai * HALF + (m + mm) * 16) * DM + col0;
                        float ss = 0.f;
#pragma unroll
                        for (int bj = 0; bj < 2; ++bj) { const f32x4 v0 = bs[mm][bj][0] + acc[ai][bj][m + mm][0], v1 = bs[mm][bj][1] + acc[ai][bj][m + mm][1];
                            ss += (v0[0] * v0[0] + v0[1] * v0[1]) + (v0[2] * v0[2] + v0[3] * v0[3]) + (v1[0] * v1[0] + v1[1] * v1[1]) + (v1[2] * v1[2] + v1[3] * v1[3]);
                            u32x4 w; w.x = pk2(v0[0], v0[1]); w.y = pk2(v0[2], v0[3]); w.z = pk2(v1[0], v1[1]); w.w = pk2(v1[2], v1[3]);
                            *(u32x4*)(out + off + bj * HALF) = w; }
                        if (ssqp) { ss += __shfl_xor(ss, 16); ss += __shfl_xor(ss, 32); if (fq == 0) ssqp[(size_t)(row0 + ai * HALF + (m + mm) * 16) * 32 + u.pn * 4 + wc] = ss; } }
                    asm volatile("" ::: "memory"); }
            } else {
                u32x4 bs[4][2];
#pragma unroll
                for (int m = 0; m < 4; ++m) { const size_t off = (size_t)(row0 + ai * HALF + m * 16) * DM + col0;
#pragma unroll
                    for (int bj = 0; bj < 2; ++bj) bs[m][bj] = *(const u32x4*)(baseb + off + bj * HALF); }
#pragma unroll
                for (int m = 0; m < 4; ++m) { const size_t off = (size_t)(row0 + ai * HALF + m * 16) * DM + col0;
                    float ss = 0.f;
#pragma unroll
                    for (int bj = 0; bj < 2; ++bj) { const u32x4 q = bs[m][bj]; const f32x4 a0 = acc[ai][bj][m][0], a1 = acc[ai][bj][m][1];
                        const float h0 = bflo(q.x) + a0[0], h1 = bfhi(q.x) + a0[1], h2 = bflo(q.y) + a0[2], h3 = bfhi(q.y) + a0[3], h4 = bflo(q.z) + a1[0], h5 = bfhi(q.z) + a1[1], h6 = bflo(q.w) + a1[2], h7 = bfhi(q.w) + a1[3];
                        ss += (h0 * h0 + h1 * h1) + (h2 * h2 + h3 * h3) + (h4 * h4 + h5 * h5) + (h6 * h6 + h7 * h7);
                        u32x4 w; w.x = pk2(h0, h1); w.y = pk2(h2, h3); w.z = pk2(h4, h5); w.w = pk2(h6, h7);
                        *(u32x4*)(out + off + bj * HALF) = w; }
                    if (ssqp) { ss += __shfl_xor(ss, 16); ss += __shfl_xor(ss, 32); if (fq == 0) ssqp[(size_t)(row0 + ai * HALF + m * 16) * 32 + u.pn * 4 + wc] = ss; } }
                asm volatile("" ::: "memory");
            }
        }
    }
};
struct EpiGates {
    static constexpr bool PERM = false;
    const bf16_t* XC; const float* b_a; const float* b_i; const float* spt; unsigned* LAU;
    __device__ __forceinline__ void operator()(const f32x4 (&acc)[2][2][4][2], const Unit& u, int wr, int wc, int fr, int fq) const {
        const int row0 = u.pm * BM + wr * 64 + fr, ch0 = u.z * 256 + u.pn * 128 + wc * 32 + 4 * fq;
#pragma unroll
        for (int n = 0; n < 2; ++n) {
            const int ch = ch0 + 16 * n;
            u32x2 xw[2][4];
#pragma unroll
            for (int ai = 0; ai < 2; ++ai)
#pragma unroll
                for (int m = 0; m < 4; ++m) xw[ai][m] = *(const u32x2*)(XC + (unsigned)(row0 + ai * HALF + m * 16) * 1024u + (unsigned)ch);
            const f32x4 ba = *(const f32x4*)(b_a + ch), bi = *(const f32x4*)(b_i + ch), sp = *(const f32x4*)(spt + ch);
#pragma unroll
            for (int ai = 0; ai < 2; ++ai)
#pragma unroll
                for (int m = 0; m < 4; ++m) {
                    const unsigned off = (unsigned)(row0 + ai * HALF + m * 16) * 1024u + (unsigned)ch;
                    const float xc[4] = {bflo(xw[ai][m].x), bfhi(xw[ai][m].x), bflo(xw[ai][m].y), bfhi(xw[ai][m].y)};
                    u32x4 w;
#pragma unroll
                    for (int j = 0; j < 4; ++j) {
                        const float r = sigmoidf_(acc[ai][0][m][n][j] + ba[j]), ig = sigmoidf_(acc[ai][1][m][n][j] + bi[j]);
                        const float la = sp[j] * r, x2 = 2.0f * la;
                        const float ser = -x2 * (1.0f + x2 * (0.5f + x2 * (0.16666667f + x2 * (0.041666668f + x2 * 0.0083333338f))));
                        const float om = (x2 > -0.25f) ? ser : (1.0f - __expf(x2));
                        w[j] = pk2(la, __builtin_amdgcn_sqrtf(om) * ig * xc[j]);
                    }
                    *(u32x4*)(LAU + off) = w;
                }
        }
    }
};
struct EpiQkv {
    static constexpr bool PERM = false;
    bf16_t* O; const float* tab; const LAS float* rt;
    __device__ __forceinline__ void operator()(f32x4 (&acc)[2][2][4][2], const Unit& u, int wr, int wc, int fr, int fq) const {
        const int row0 = u.pm * BM + wr * 64 + fr, col0 = u.pn * BM + wc * 32 + 4 * fq;
        const int sec = u.pn >> 3;
        const float scale = (sec == 0) ? 0.08838834764831845f : 1.0f;
#pragma unroll
        for (int ai = 0; ai < 2; ++ai)
#pragma unroll
            for (int m = 0; m < 4; ++m) {
                const int row = row0 + ai * HALF + m * 16;
                if (sec < 2 && wc == 0) {
                    const f32x4 t0 = *(const f32x4*)(tab + (size_t)row * 32 + 8 * fq), t1 = *(const f32x4*)(tab + (size_t)row * 32 + 8 * fq + 4);
                    const float cs[4] = {t0[0], t0[2], t1[0], t1[2]}, sn[4] = {t0[1], t0[3], t1[1], t1[3]};
#pragma unroll
                    for (int bj = 0; bj < 2; ++bj)
#pragma unroll
                        for (int j = 0; j < 4; ++j) { const float a = acc[ai][bj][m][0][j], b = acc[ai][bj][m][1][j];
                            acc[ai][bj][m][0][j] = a * cs[j] - b * sn[j]; acc[ai][bj][m][1][j] = b * cs[j] + a * sn[j]; }
                }
                bf16_t* rowp = O + (size_t)row * INC + col0;
#pragma unroll
                for (int bj = 0; bj < 2; ++bj)
#pragma unroll
                    for (int n = 0; n < 2; ++n) { const f32x4 v = acc[ai][bj][m][n] * (scale * rt[u.i * 256 + wr * 64 + fr + ai * HALF + m * 16]); u32x2 w; w.x = pk2(v[0], v[1]); w.y = pk2(v[2], v[3]); *(u32x2*)(rowp + bj * HALF + n * 16) = w; }
            }
    }
};
}

__device__ __forceinline__ void transpose_item(const float* W, int K, int N, bf16_t* WT, int gate, const float* kscale, LAS float* scr, int item, int lane) {
    const int nblk = N / 64, kb = item / nblk, nb = item % nblk, k0 = 64 * kb, n0 = 64 * nb;
    const int c4 = (lane & 15) * 4, kr = lane >> 4;
    f32x4 v[16];
#pragma unroll
    for (int i = 0; i < 16; ++i) v[i] = __builtin_nontemporal_load((const f32x4*)(W + (size_t)(k0 + 4 * i + kr) * N + n0 + c4));
#pragma unroll
    for (int i = 0; i < 16; ++i) { LAS float* d = scr + (4 * i + kr) * 65 + c4; d[0] = v[i][0]; d[1] = v[i][1]; d[2] = v[i][2]; d[3] = v[i][3]; }
    lds_wait();
    const int c = lane & 7;
    f32x4 k0v = {1.f, 1.f, 1.f, 1.f}, k1v = k0v;
    if (kscale) { k0v = *(const f32x4*)(kscale + k0 + 8 * c); k1v = *(const f32x4*)(kscale + k0 + 8 * c + 4); }
#pragma unroll
    for (int j = 0; j < 8; ++j) { const int n = (lane >> 3) + 8 * j; const LAS float* s = scr + (8 * c) * 65 + n;
        u32x4 o; o.x = pk2(s[0 * 65] * k0v[0], s[1 * 65] * k0v[1]); o.y = pk2(s[2 * 65] * k0v[2], s[3 * 65] * k0v[3]); o.z = pk2(s[4 * 65] * k1v[0], s[5 * 65] * k1v[1]); o.w = pk2(s[6 * 65] * k1v[2], s[7 * 65] * k1v[3]);
        const int nn = n0 + n; const int row = gate < 0 ? nn : (256 * (nn >> 7) + 128 * gate + (nn & 127));
        *(u32x4*)(WT + (size_t)row * K + k0 + 8 * c) = o; }
    lds_wait();
}
__device__ __forceinline__ void transpose_job(const float* W, int K, int N, bf16_t* WT, int gate, const float* kscale, LAS unsigned char* lds, int gw, int NGW, int wave, int lane) {
    LAS float* scr = (LAS float*)(lds + wave * 16640);
    const int items = (K / 64) * (N / 64);
    for (int it = gw; it < items; it += NGW) transpose_item(W, K, N, WT, gate, kscale, scr, it, lane);
}
__device__ __forceinline__ void norm_rows_bf16(const float* X, const float* gain, bf16_t* O, int gw, int NGW, int lane) {
    for (int m = gw; m < NTOK; m += NGW) {
        const f32x4* xr = (const f32x4*)(X + (size_t)m * DM) + lane;
        f32x4 v[8]; float s = 0.f;
#pragma unroll
        for (int j = 0; j < 8; ++j) { v[j] = __builtin_nontemporal_load(xr + 64 * j); s += (v[j].x * v[j].x + v[j].y * v[j].y) + (v[j].z * v[j].z + v[j].w * v[j].w); }
        const float rstd = 1.0f / sqrtf(wave_sum(s) * (1.0f / DM) + 1e-6f);
        u32x2* o8 = (u32x2*)(O + (size_t)m * DM) + lane;
#pragma unroll
        for (int j = 0; j < 8; ++j) { const f32x4 g = ((const f32x4*)gain)[lane + 64 * j]; u32x2 w; w.x = pk2(v[j].x * rstd * g.x, v[j].y * rstd * g.y); w.y = pk2(v[j].z * rstd * g.z, v[j].w * rstd * g.w); o8[64 * j] = w; }
    }
}
template <bool OUT_F32>
__device__ __forceinline__ void norm_rows_from_bf16(const bf16_t* H, const float* gain, bf16_t* OB, float* OF, int gw, int NGW, int lane) {
    for (int m = gw; m < NTOK; m += NGW) {
        const u32x4* hr = (const u32x4*)(H + (size_t)m * DM) + lane;
        u32x4 q[4]; float v[4][8]; float s = 0.f;
#pragma unroll
        for (int j = 0; j < 4; ++j) q[j] = __builtin_nontemporal_load(hr + 64 * j);
#pragma unroll
        for (int j = 0; j < 4; ++j) { v[j][0] = bflo(q[j].x); v[j][1] = bfhi(q[j].x); v[j][2] = bflo(q[j].y); v[j][3] = bfhi(q[j].y); v[j][4] = bflo(q[j].z); v[j][5] = bfhi(q[j].z); v[j][6] = bflo(q[j].w); v[j][7] = bfhi(q[j].w);
#pragma unroll
            for (int e = 0; e < 8; ++e) s += v[j][e] * v[j][e]; }
        const float rstd = 1.0f / sqrtf(wave_sum(s) * (1.0f / DM) + 1e-6f);
#pragma unroll
        for (int j = 0; j < 4; ++j) {
            const int c0 = 8 * (lane + 64 * j);
            const f32x4 g0 = *(const f32x4*)(gain + c0), g1 = *(const f32x4*)(gain + c0 + 4);
            const float o0 = v[j][0] * rstd * g0[0], o1 = v[j][1] * rstd * g0[1], o2 = v[j][2] * rstd * g0[2], o3 = v[j][3] * rstd * g0[3];
            const float o4 = v[j][4] * rstd * g1[0], o5 = v[j][5] * rstd * g1[1], o6 = v[j][6] * rstd * g1[2], o7 = v[j][7] * rstd * g1[3];
            if (OUT_F32) { float* op = OF + (size_t)m * DM + c0; __builtin_nontemporal_store((f32x4){o0, o1, o2, o3}, (f32x4*)op); __builtin_nontemporal_store((f32x4){o4, o5, o6, o7}, (f32x4*)(op + 4)); }
            else { u32x4 w; w.x = pk2(o0, o1); w.y = pk2(o2, o3); w.z = pk2(o4, o5); w.w = pk2(o6, o7); *(u32x4*)(OB + (size_t)m * DM + c0) = w; }
        }
    }
}
__device__ __forceinline__ void norm_rows_f32_inplace(float* X, const float* gain, int gw, int NGW, int lane) {
    for (int m = gw; m < NTOK; m += NGW) {
        f32x4* xr = (f32x4*)(X + (size_t)m * DM) + lane;
        f32x4 v[8]; float s = 0.f;
#pragma unroll
        for (int j = 0; j < 8; ++j) { v[j] = xr[64 * j]; s += (v[j].x * v[j].x + v[j].y * v[j].y) + (v[j].z * v[j].z + v[j].w * v[j].w); }
        const float rstd = 1.0f / sqrtf(wave_sum(s) * (1.0f / DM) + 1e-6f);
#pragma unroll
        for (int j = 0; j < 8; ++j) { const f32x4 g = ((const f32x4*)gain)[lane + 64 * j]; xr[64 * j] = v[j] * rstd * g; }
    }
}

constexpr int HP = 136;
__device__ __forceinline__ bf16x8 tr_frag(unsigned base, int rowbase, int col0, int lane) {
    const int g = lane >> 4, idx = lane & 15, q = idx >> 2, p = idx & 3;
    const unsigned a0 = base + (unsigned)(((rowbase + 8 * g + q) * HP + col0 + 4 * p) * 2);
    const s16x4 lo = tr_read(a0), hi = tr_read(a0 + 4 * HP * 2);
    return cat8(lo, hi);
}

struct QTile { bf16x8 q[4]; f32x4 o[8]; float m, l; };
struct KVRegs { u32x4 k[8], v[8]; };

#define TR8(r, base, o0) asm volatile( \
    "ds_read_b64_tr_b16 %0, %8 offset:" #o0 "+0\n\tds_read_b64_tr_b16 %1, %8 offset:" #o0 "+4352\n\t" \
    "ds_read_b64_tr_b16 %2, %8 offset:" #o0 "+32\n\tds_read_b64_tr_b16 %3, %8 offset:" #o0 "+4384\n\t" \
    "ds_read_b64_tr_b16 %4, %8 offset:" #o0 "+64\n\tds_read_b64_tr_b16 %5, %8 offset:" #o0 "+4416\n\t" \
    "ds_read_b64_tr_b16 %6, %8 offset:" #o0 "+96\n\tds_read_b64_tr_b16 %7, %8 offset:" #o0 "+4448\n\t" \
    "s_waitcnt lgkmcnt(0)" \
    : "=&v"(r[0]), "=&v"(r[1]), "=&v"(r[2]), "=&v"(r[3]), "=&v"(r[4]), "=&v"(r[5]), "=&v"(r[6]), "=&v"(r[7]) : "v"(base) : "memory")

#define TR8B(r, base, o0) asm volatile( \
    "ds_read_b64_tr_b16 %0, %8 offset:" #o0 "+0\n\tds_read_b64_tr_b16 %1, %8 offset:" #o0 "+1088\n\t" \
    "ds_read_b64_tr_b16 %2, %8 offset:" #o0 "+32\n\tds_read_b64_tr_b16 %3, %8 offset:" #o0 "+1120\n\t" \
    "ds_read_b64_tr_b16 %4, %8 offset:" #o0 "+64\n\tds_read_b64_tr_b16 %5, %8 offset:" #o0 "+1152\n\t" \
    "ds_read_b64_tr_b16 %6, %8 offset:" #o0 "+96\n\tds_read_b64_tr_b16 %7, %8 offset:" #o0 "+1184\n\t" \
    "s_waitcnt lgkmcnt(0)" \
    : "=&v"(r[0]), "=&v"(r[1]), "=&v"(r[2]), "=&v"(r[3]), "=&v"(r[4]), "=&v"(r[5]), "=&v"(r[6]), "=&v"(r[7]) : "v"(base) : "memory")

__device__ __forceinline__ void attn_tile_update(QTile& t, const int mq, int mk0, unsigned VSa, LAS unsigned char* KS, int lane) {
    const int fr = lane & 15, fq = lane >> 4;
    f32x4 s0 = {0.f, 0.f, 0.f, 0.f}, s1 = {0.f, 0.f, 0.f, 0.f};
#pragma unroll
    for (int kk = 0; kk < 4; ++kk) {
        const bf16x8 a0 = *(const LAS bf16x8*)(KS + ((fr)*HP + 32 * kk + 8 * fq) * 2);
        const bf16x8 a1 = *(const LAS bf16x8*)(KS + ((16 + fr) * HP + 32 * kk + 8 * fq) * 2);
        s0 = __builtin_amdgcn_mfma_f32_16x16x32_bf16(a0, t.q[kk], s0, 0, 0, 0);
        s1 = __builtin_amdgcn_mfma_f32_16x16x32_bf16(a1, t.q[kk], s1, 0, 0, 0);
    }
    const float NEG = -__builtin_inff();
    float mx = NEG;
    bool v0[4], v1[4];
#pragma unroll
    for (int j = 0; j < 4; ++j) {
        const int mk = mk0 + 4 * fq + j, jd = mq - mk;
        v0[j] = (jd >= 0) && (jd <= 128) && (mk >= 0);
        v1[j] = (jd - 16 >= 0) && (jd - 16 <= 128) && (mk + 16 >= 0);
        if (v0[j]) mx = fmaxf(mx, s0[j]);
        if (v1[j]) mx = fmaxf(mx, s1[j]);
    }
    mx = fmaxf(mx, __shfl_xor(mx, 16)); mx = fmaxf(mx, __shfl_xor(mx, 32));
    const float mnew = fmaxf(t.m, mx);
    const float muse = (mnew == NEG) ? 0.f : mnew;
    const float alpha = __expf(t.m - muse);
    f32x4 p0, p1; float ps = 0.f;
#pragma unroll
    for (int j = 0; j < 4; ++j) { p0[j] = v0[j] ? __expf(s0[j] - muse) : 0.f; p1[j] = v1[j] ? __expf(s1[j] - muse) : 0.f; ps += p0[j] + p1[j]; }
    t.l = t.l * alpha + ps; t.m = mnew;
#pragma unroll
    for (int dt = 0; dt < 8; ++dt) t.o[dt] *= alpha;
    const bf16x8 pf = pack8(p0, p1);
    const unsigned vb = VSa + (unsigned)(((4 * fq + (fr >> 2)) * HP + 4 * (fr & 3)) * 2);
    s16x4 ra[8], rb[8];
    TR8(ra, vb, 0);
    TR8(rb, vb, 128);
#pragma unroll
    for (int dt = 0; dt < 4; ++dt) t.o[dt] = __builtin_amdgcn_mfma_f32_16x16x32_bf16(cat8(ra[2 * dt], ra[2 * dt + 1]), pf, t.o[dt], 0, 0, 0);
#pragma unroll
    for (int dt = 0; dt < 4; ++dt) t.o[4 + dt] = __builtin_amdgcn_mfma_f32_16x16x32_bf16(cat8(rb[2 * dt], rb[2 * dt + 1]), pf, t.o[4 + dt], 0, 0, 0);
}

__device__ __forceinline__ void attn_pair_update(QTile& t0, const int mq0, QTile& t1, const int mq1, int mk0, unsigned VSa, LAS unsigned char* KS, int lane) {
    const int fr = lane & 15, fq = lane >> 4;
    f32x4 s00 = {0.f, 0.f, 0.f, 0.f}, s01 = s00, s10 = s00, s11 = s00;
#pragma unroll
    for (int kk = 0; kk < 4; ++kk) {
        const bf16x8 a0 = *(const LAS bf16x8*)(KS + ((fr)*HP + 32 * kk + 8 * fq) * 2);
        const bf16x8 a1 = *(const LAS bf16x8*)(KS + ((16 + fr) * HP + 32 * kk + 8 * fq) * 2);
        s00 = __builtin_amdgcn_mfma_f32_16x16x32_bf16(a0, t0.q[kk], s00, 0, 0, 0);
        s01 = __builtin_amdgcn_mfma_f32_16x16x32_bf16(a1, t0.q[kk], s01, 0, 0, 0);
        s10 = __builtin_amdgcn_mfma_f32_16x16x32_bf16(a0, t1.q[kk], s10, 0, 0, 0);
        s11 = __builtin_amdgcn_mfma_f32_16x16x32_bf16(a1, t1.q[kk], s11, 0, 0, 0);
    }
    const float NEG = -__builtin_inff();
    float mx0 = NEG, mx1 = NEG;
#pragma unroll
    for (int j = 0; j < 4; ++j) {
        const int mk = mk0 + 4 * fq + j, jd0 = mq0 - mk, jd1 = mq1 - mk;
        const bool kv0 = (mk >= 0), kv1 = (mk + 16 >= 0);
        if (!((jd0 >= 0) && (jd0 <= 128) && kv0)) s00[j] = NEG;
        if (!((jd0 - 16 >= 0) && (jd0 - 16 <= 128) && kv1)) s01[j] = NEG;
        if (!((jd1 >= 0) && (jd1 <= 128) && kv0)) s10[j] = NEG;
        if (!((jd1 - 16 >= 0) && (jd1 - 16 <= 128) && kv1)) s11[j] = NEG;
        mx0 = fmaxf(mx0, fmaxf(s00[j], s01[j])); mx1 = fmaxf(mx1, fmaxf(s10[j], s11[j]));
    }
    { const float a = __shfl_xor(mx0, 16), b = __shfl_xor(mx1, 16); mx0 = fmaxf(mx0, a); mx1 = fmaxf(mx1, b); }
    { const float a = __shfl_xor(mx0, 32), b = __shfl_xor(mx1, 32); mx0 = fmaxf(mx0, a); mx1 = fmaxf(mx1, b); }
    const float mn0 = fmaxf(t0.m, mx0), mn1 = fmaxf(t1.m, mx1);
    const float mu0 = (mn0 == NEG) ? 0.f : mn0, mu1 = (mn1 == NEG) ? 0.f : mn1;
    const float al0 = __expf(t0.m - mu0), al1 = __expf(t1.m - mu1);
    f32x4 p00, p01, p10, p11; float ps0 = 0.f, ps1 = 0.f;
#pragma unroll
    for (int j = 0; j < 4; ++j) {
        p00[j] = __expf(s00[j] - mu0); p01[j] = __expf(s01[j] - mu0); p10[j] = __expf(s10[j] - mu1); p11[j] = __expf(s11[j] - mu1);
        ps0 += p00[j] + p01[j]; ps1 += p10[j] + p11[j];
    }
    t0.l = t0.l * al0 + ps0; t0.m = mn0; t1.l = t1.l * al1 + ps1; t1.m = mn1;
#pragma unroll
    for (int dt = 0; dt < 8; ++dt) { t0.o[dt] *= al0; t1.o[dt] *= al1; }
    const bf16x8 pf0 = pack8(p00, p01), pf1 = pack8(p10, p11);
    const unsigned vb = VSa + (unsigned)(((4 * fq + (fr >> 2)) * HP + 4 * (fr & 3)) * 2);
    s16x4 ra[8];
    TR8(ra, vb, 0);
#pragma unroll
    for (int dt = 0; dt < 4; ++dt) { const bf16x8 vf = cat8(ra[2 * dt], ra[2 * dt + 1]);
        t0.o[dt] = __builtin_amdgcn_mfma_f32_16x16x32_bf16(vf, pf0, t0.o[dt], 0, 0, 0); t1.o[dt] = __builtin_amdgcn_mfma_f32_16x16x32_bf16(vf, pf1, t1.o[dt], 0, 0, 0); }
    s16x4 rb[8];
    TR8(rb, vb, 128);
#pragma unroll
    for (int dt = 0; dt < 4; ++dt) { const bf16x8 vf = cat8(rb[2 * dt], rb[2 * dt + 1]);
        t0.o[4 + dt] = __builtin_amdgcn_mfma_f32_16x16x32_bf16(vf, pf0, t0.o[4 + dt], 0, 0, 0); t1.o[4 + dt] = __builtin_amdgcn_mfma_f32_16x16x32_bf16(vf, pf1, t1.o[4 + dt], 0, 0, 0); }
}

__device__ __forceinline__ void attn_load(KVRegs& R, const bf16_t* QKV, int b, int h, int dsh, int rd, int mk0, int lane) {
#pragma unroll
    for (int it = 0; it < 8; ++it) {
        const int kidx = 4 * it + (lane >> 4), ch = lane & 15;
        int mk = mk0 + kidx; mk = mk < 0 ? 0 : mk;
        const size_t row = (size_t)b * SEQ + ((size_t)mk << dsh) + rd;
        R.k[it] = *(const u32x4*)(QKV + row * INC + 2048 + h * 128 + 8 * ch);
        R.v[it] = *(const u32x4*)(QKV + row * INC + 4096 + h * 128 + 8 * ch);
    }
}
__device__ __forceinline__ void attn_stage(const KVRegs& R, LAS unsigned char* KS, LAS unsigned char* VS, int lane) {
#pragma unroll
    for (int it = 0; it < 8; ++it) {
        const int kidx = 4 * it + (lane >> 4), ch = lane & 15;
        *(LAS u32x4*)(KS + (kidx * HP + 8 * ch) * 2) = R.k[it];
        *(LAS u32x4*)(VS + (kidx * HP + 8 * ch) * 2) = R.v[it];
    }
    lds_wait();
}
template <bool T0, bool T1>
__device__ __forceinline__ void attn_branch(const bf16_t* QKV, int b, int h, int n, int dsh, int rd, int mkbase, int ng, QTile& t0, int r0, QTile& t1, int r1, LAS unsigned char* KS, LAS unsigned char* VS, int lane) {
    int g = 0;
    while (g < ng && mkbase + 32 * g + 31 < 0) ++g;
    if (g >= ng) return;
    KVRegs R;
    attn_load(R, QKV, b, h, dsh, rd, mkbase + 32 * g, lane);
    const unsigned VSa = lds_addr_of(VS);
#pragma unroll 1
    for (; g < ng; ++g) {
        const int mk0 = mkbase + 32 * g;
        attn_stage(R, KS, VS, lane);
        if (g + 1 < ng) attn_load(R, QKV, b, h, dsh, rd, mk0 + 32, lane);
        const int mqa = (256 * n + 16 * (lane & 15) + r0 - rd) >> dsh, mqb = (256 * n + 16 * (lane & 15) + r1 - rd) >> dsh;
        if (T0 && T1) attn_pair_update(t0, mqa, t1, mqb, mk0, VSa, KS, lane);
        else if (T0) attn_tile_update(t0, mqa, mk0, VSa, KS, lane);
        else attn_tile_update(t1, mqb, mk0, VSa, KS, lane);
        lds_wait();
    }
}

__device__ __forceinline__ void attn_tile_init(QTile& t, const bf16_t* QKV, int b, int h, int n, int r, int lane) {
    const int fr = lane & 15, fq = lane >> 4;
    const size_t row = (size_t)b * SEQ + 256 * n + 16 * fr + r;
#pragma unroll
    for (int kk = 0; kk < 4; ++kk) t.q[kk] = *(const bf16x8*)(QKV + row * INC + h * 128 + 32 * kk + 8 * fq);
#pragma unroll
    for (int dt = 0; dt < 8; ++dt) t.o[dt] = (f32x4){0.f, 0.f, 0.f, 0.f};
    t.m = -__builtin_inff(); t.l = 0.f;
}
__device__ __forceinline__ unsigned ex_off(int p, int dt, int fq) { return (unsigned)(p * 528 + ((dt ^ ((p >> 4) & 7)) * 64) + fq * 16); }
__device__ __forceinline__ void attn_q_load(QTile& t, const bf16_t* QKV, size_t row, int h, int lane) {
    const int fq = lane >> 4;
#pragma unroll
    for (int kk = 0; kk < 4; ++kk) t.q[kk] = *(const bf16x8*)(QKV + row * INC + h * 128 + 32 * kk + 8 * fq);
}
__device__ __forceinline__ void attn_dump(QTile& t, LAS unsigned char* lds, int p, int lane) {
    asm volatile("" : "+v"(p));
    const int fq = lane >> 4;
    float l = t.l; l += __shfl_xor(l, 16); l += __shfl_xor(l, 32);
#pragma unroll
    for (int dt = 0; dt < 8; ++dt) *(LAS f32x4*)(lds + ex_off(p, dt, fq)) = t.o[dt];
    if (fq == 0) *(LAS f32x2*)(lds + 135168 + p * 8) = (f32x2){t.m, l};
}
__device__ __forceinline__ void attn_pick(QTile& t, LAS unsigned char* lds, int p, int lane) {
    asm volatile("" : "+v"(p));
    const int fq = lane >> 4;
#pragma unroll
    for (int dt = 0; dt < 8; ++dt) t.o[dt] = *(const LAS f32x4*)(lds + ex_off(p, dt, fq));
    const f32x2 ml = *(const LAS f32x2*)(lds + 135168 + p * 8);
    t.m = ml.x; t.l = ml.y * 0.25f;
}
__device__ __forceinline__ void attn_tile_store(QTile& t, bf16_t* ATT, int b, int h, int n, int r, int lane) {
    const int fr = lane & 15, fq = lane >> 4;
    float l = t.l; l += __shfl_xor(l, 16); l += __shfl_xor(l, 32);
    const float inv = 1.0f / l;
    const size_t row = (size_t)b * SEQ + 256 * n + 16 * fr + r;
#pragma unroll
    for (int dt = 0; dt < 8; ++dt) { const f32x4 v = t.o[dt] * inv; u32x2 w; w.x = pk2(v[0], v[1]); w.y = pk2(v[2], v[3]); *(u32x2*)(ATT + row * DM + h * 128 + 16 * dt + 4 * fq) = w; }
}

__device__ __forceinline__ void fill_rstd_table(LAS float* RT, const float* SSQP, const pg8::Order& S, int tid) {
    pg8::Unit uu;
    for (int i = 0; S.next(i, uu); ++i) {
        if (tid < 256) {
            const f32x4* pp = (const f32x4*)(SSQP + (size_t)(uu.pm * 256 + tid) * 32);
            float sacc = 0.f;
#pragma unroll
            for (int q = 0; q < 8; ++q) { const f32x4 v = pp[q]; sacc += (v[0] + v[1]) + (v[2] + v[3]); }
            RT[i * 256 + tid] = 1.0f / sqrtf(sacc * (1.0f / DM) + 1e-6f);
        }
    }
    __syncthreads();
}

__device__ __forceinline__ void grid_barrier(unsigned* ctr, unsigned target, int wave) {
    int lane; asm volatile("v_mbcnt_lo_u32_b32 %0, -1, 0\n\tv_mbcnt_hi_u32_b32 %0, -1, %0" : "=v"(lane));
    asm volatile("s_waitcnt vmcnt(0) lgkmcnt(0)" ::: "memory");
    __syncthreads();
    if (wave == 0) {
        __builtin_amdgcn_fence(__ATOMIC_RELEASE, "agent");
        if (lane == 0) {
            __hip_atomic_fetch_add(ctr, 1u, __ATOMIC_RELAXED, __HIP_MEMORY_SCOPE_AGENT);
            while (__hip_atomic_load(ctr, __ATOMIC_RELAXED, __HIP_MEMORY_SCOPE_AGENT) < target) __builtin_amdgcn_s_sleep(1);
        }
        __builtin_amdgcn_fence(__ATOMIC_ACQUIRE, "agent");
        asm volatile("s_waitcnt vmcnt(0)" ::: "memory");
    }
    __syncthreads();
}

__global__ void __launch_bounds__(512, 2) mega(Params p, int ph_lo, int ph_hi) {
    extern __shared__ __attribute__((aligned(16))) unsigned char lds_raw[];
    LAS unsigned char* lds = (LAS unsigned char*)lds_raw;
    cg::grid_group grid = cg::this_grid();
    const int wave = __builtin_amdgcn_readfirstlane(threadIdx.x >> 6);
    const int G = gridDim.x, bid = blockIdx.x;
    const int gw = bid * 8 + wave, NGW = G * 8;
    const int NGT = G * 512;
    unsigned char* ws = p.ws;
    bf16_t* WA = (bf16_t*)(ws + WS_WA); bf16_t* WB = (bf16_t*)(ws + WS_WB); bf16_t* W1 = (bf16_t*)(ws + WS_W1); bf16_t* W2 = (bf16_t*)(ws + WS_W2); bf16_t* WG = (bf16_t*)(ws + WS_WG);
    f32x2* AGG = (f32x2*)(ws + WS_AGG); float* DK = (float*)(ws + WS_DK); float* TAB = (float*)(ws + WS_TAB);
    bf16_t* XN = (bf16_t*)(ws + WS_XN); bf16_t* BIG = (bf16_t*)(ws + WS_BIG); float* SSQP = (float*)(ws + WS_TAB + 2 * MiB); LAS float* RT = (LAS float*)(lds + pg8::STAGE_BYTES);
    unsigned* LAU = (unsigned*)(ws + WS_LA); bf16_t* HB = (bf16_t*)(ws + WS_LU);
    bf16_t* SSTB = (bf16_t*)p.out;
    grid.sync();
    int ph = 0, nbar = 0;
    unsigned* CTR = (unsigned*)(ws + WS_CTR); float* SPT = (float*)(ws + WS_CTR + 4096);
#ifndef DUPMASK
#define DUPMASK 0
#endif
#define PHASE_BEGIN if (ph >= ph_lo && ph < ph_hi) { for (int rep = 0; rep <= ((DUPMASK >> ph) & 1); ++rep) { if (ph > ph_lo || rep > 0) { \
        ++nbar; grid_barrier(CTR, (unsigned)nbar * (unsigned)G, wave); } \
    int lane; asm volatile("v_mbcnt_lo_u32_b32 %0, -1, 0\n\tv_mbcnt_hi_u32_b32 %0, -1, %0" : "=v"(lane)); const int tid = wave * 64 + lane; const int gt = bid * 512 + tid; (void)gt;
#define PHASE_END } } ++ph;

    PHASE_BEGIN
        transpose_job(p.w_in, DM, INC, WA, -1, nullptr, lds, gw, NGW, wave, lane);
#pragma unroll 1
        for (int hh = 0; hh < 4; ++hh) {
            transpose_job(p.w_a + (size_t)hh * 65536, 256, 256, WG + (size_t)hh * 131072, 0, nullptr, lds, gw, NGW, wave, lane);
            transpose_job(p.w_i + (size_t)hh * 65536, 256, 256, WG + (size_t)hh * 131072, 1, nullptr, lds, gw, NGW, wave, lane);
        }
        transpose_job(p.w_out, DM, DM, WB, -1, nullptr, lds, gw, NGW, wave, lane);
        transpose_job(p.w1, DM, DFF, W1, -1, p.norm_mlp, lds, gw, NGW, wave, lane);
        transpose_job(p.w2, DFF, DM, W2, -1, nullptr, lds, gw, NGW, wave, lane);
        norm_rows_bf16(p.x, p.norm_mix, XN, gw, NGW, lane);
        if (gt < 1024) SPT[gt] = -8.0f * log1pf(__expf(-p.lam[gt]));
    PHASE_END

    PHASE_BEGIN
        pg8::Gemm g{XN, WA, DM, DM, DM, 0, 0}; pg8::Order S; S.init(NTOK, INC, 1, G, bid);
        pg8::EpiBf16<0> E{BIG, INC, nullptr};
        pg8::gemm_phase(lds, g, S, E, tid);
    PHASE_END

    PHASE_BEGIN
        for (int idx = gt; idx < NTOK * 128; idx += NGT) {
            const int t = idx >> 7, c8 = (idx & 127) * 8, pos = t & (SEQ - 1);
            float a[8];
            { const f32x4 b0 = *(const f32x4*)(p.conv_b + c8), b1 = *(const f32x4*)(p.conv_b + c8 + 4); a[0] = b0[0]; a[1] = b0[1]; a[2] = b0[2]; a[3] = b0[3]; a[4] = b1[0]; a[5] = b1[1]; a[6] = b1[2]; a[7] = b1[3]; }
#pragma unroll
            for (int j = 0; j < 4; ++j) {
                if (pos - 3 + j >= 0) {
                    const u32x4 xw = *(const u32x4*)(BIG + (size_t)(t - 3 + j) * INC + c8);
                    const f32x4 w0 = *(const f32x4*)(p.conv_w + j * 1024 + c8), w1 = *(const f32x4*)(p.conv_w + j * 1024 + c8 + 4);
                    a[0] += w0[0] * bflo(xw.x); a[1] += w0[1] * bfhi(xw.x); a[2] += w0[2] * bflo(xw.y); a[3] += w0[3] * bfhi(xw.y);
                    a[4] += w1[0] * bflo(xw.z); a[5] += w1[1] * bfhi(xw.z); a[6] += w1[2] * bflo(xw.w); a[7] += w1[3] * bfhi(xw.w);
                }
            }
            u32x4 o; o.x = pk2(a[0], a[1]); o.y = pk2(a[2], a[3]); o.z = pk2(a[4], a[5]); o.w = pk2(a[6], a[7]);
            *(u32x4*)(XN + (size_t)t * 1024 + c8) = o;
        }
        {
            LAS unsigned char* KT = lds; LAS unsigned char* VS = lds + 64 * HP * 2; LAS float* EX = (LAS float*)(lds + 2 * 64 * HP * 2);
            const int k = tid & 127, I = tid >> 7;
            const int fr = lane & 15, fq = lane >> 4;
            for (int unit = bid; unit < 2048; unit += G) {
                const int c = unit & 127, bh = unit >> 7, h = bh & 7, b = bh >> 3;
                const size_t row0 = (size_t)b * SEQ + c * 64;
                const int chn = h * 128 + k;
                const float l0 = p.lb_logits[chn], l1 = p.lb_logits[1024 + chn], l2 = p.lb_logits[2048 + chn];
                bf16_t fzr[16];
#pragma unroll
                for (int i = 0; i < 16; ++i) fzr[i] = BIG[(row0 + 16 * I + i) * INC + 3072 + chn];
                u32x4 vst[2];
#pragma unroll
                for (int i = 0; i < 2; ++i) { const int idx = tid + 512 * i, r = idx >> 4, ch = idx & 15; vst[i] = *(const u32x4*)(BIG + (row0 + r) * INC + 4096 + h * 128 + 8 * ch); }
                __builtin_amdgcn_sched_barrier(0);
                float lb; { const float mxl = fmaxf(l0, fmaxf(l1, l2)); const float e0 = __expf(l0 - mxl), e1 = __expf(l1 - mxl), e2 = __expf(l2 - mxl); lb = e0 / (e0 + e1 + e2); }
                float lf[16], kk[16]; float tot = 0.f;
#pragma unroll
                for (int i = 0; i < 16; ++i) { const float fz = bf2f(fzr[i]); const float sg = sigmoidf_(fz); lf[i] = __logf(lb + (1.0f - lb) * sg); kk[i] = (1.0f - lb) * __builtin_amdgcn_rcpf(1.0f + __expf(fz)); tot += lf[i]; }
                __syncthreads();
                EX[I * 128 + k] = tot;
#pragma unroll
                for (int i = 0; i < 2; ++i) { const int idx = tid + 512 * i, r = idx >> 4, ch = idx & 15; *(LAS u32x4*)(VS + (r * HP + 8 * ch) * 2) = vst[i]; }
                __syncthreads();
                float prefix = 0.f, total = 0.f;
#pragma unroll
                for (int ii = 0; ii < 4; ++ii) { const float e = EX[ii * 128 + k]; total += e; if (ii < I) prefix += e; }
                if (I == 0) DK[(size_t)unit * 128 + k] = __expf(total);
                float bc = prefix;
#pragma unroll
                for (int i = 0; i < 16; ++i) { bc += lf[i]; const float kt = kk[i] * __expf(total - bc); *(LAS bf16_t*)(KT + ((16 * I + i) * HP + k) * 2) = (bf16_t)(pk2(kt, 0.f) & 0xffffu); }
                __syncthreads();
                const unsigned KTa = lds_addr_of(KT), VSa = lds_addr_of(VS);
                f32x4 acc[8];
#pragma unroll
                for (int vt = 0; vt < 8; ++vt) acc[vt] = (f32x4){0.f, 0.f, 0.f, 0.f};
#pragma unroll
                for (int k2 = 0; k2 < 2; ++k2) {
                    const bf16x8 a = tr_frag(KTa, 32 * k2, 16 * wave, lane);
                    const unsigned vb = VSa + (unsigned)(((32 * k2 + 8 * fq + (fr >> 2)) * HP + 4 * (fr & 3)) * 2);
                    s16x4 ra[8], rb[8];
                    TR8B(ra, vb, 0); TR8B(rb, vb, 128);
#pragma unroll
                    for (int vt = 0; vt < 4; ++vt) acc[vt] = __builtin_amdgcn_mfma_f32_16x16x32_bf16(a, cat8(ra[2 * vt], ra[2 * vt + 1]), acc[vt], 0, 0, 0);
#pragma unroll
                    for (int vt = 0; vt < 4; ++vt) acc[4 + vt] = __builtin_amdgcn_mfma_f32_16x16x32_bf16(a, cat8(rb[2 * vt], rb[2 * vt + 1]), acc[4 + vt], 0, 0, 0);
                }
#pragma unroll
                for (int vt = 0; vt < 8; ++vt) { u32x2 w; w.x = pk2(acc[vt][0], acc[vt][1]); w.y = pk2(acc[vt][2], acc[vt][3]);
                    *(u32x2*)(SSTB + ((size_t)unit * 128 + 16 * vt + fr) * 128 + 16 * wave + 4 * fq) = w; }
            }
            __syncthreads();
        }
    PHASE_END

    PHASE_BEGIN
        {
            pg8::Gemm g{XN, WG, 1024, 256, 256, (size_t)256 * 2, (size_t)512 * 256 * 2}; pg8::Order S; S.init(NTOK, 512, 4, G, bid);
            pg8::EpiGates E{XN, p.b_a, p.b_i, SPT, LAU};
            pg8::gemm_phase(lds, g, S, E, tid);
        }
        int lane2; asm volatile("v_mbcnt_lo_u32_b32 %0, -1, 0\n\tv_mbcnt_hi_u32_b32 %0, -1, %0" : "=v"(lane2));
        {
            pg8::Order S; S.init(NTOK, 512, 4, G, bid); pg8::Unit uu;
            const int tid2 = wave * 64 + lane2, half = tid2 >> 8, sub = (tid2 >> 7) & 1, chl = tid2 & 127;
            for (int i = 0; S.next(i, uu); ++i) {
                const int ch = uu.z * 256 + uu.pn * 128 + chl, cidx = 2 * uu.pm + half;
                const unsigned* src = LAU + ((size_t)cidx * 128 + 64 * sub) * 1024 + ch;
                float P = 1.f, H = 0.f;
#pragma unroll 16
                for (int t = 0; t < 64; ++t) { const unsigned w = src[(size_t)t * 1024]; const float a = __expf(bflo(w)); H = a * H + bfhi(w); P *= a; }
                LAS float* X2 = (LAS float*)lds;
                if (sub == 1) { X2[(half * 128 + chl) * 2] = P; X2[(half * 128 + chl) * 2 + 1] = H; }
                __syncthreads();
                if (sub == 0) { const float P1 = X2[(half * 128 + chl) * 2], H1 = X2[(half * 128 + chl) * 2 + 1]; AGG[(size_t)cidx * 1024 + ch] = (f32x2){P * P1, P1 * H + H1}; }
                __syncthreads();
            }
        }
        if (rep == 0) for (int gid = bid * 512 + wave * 64 + lane2; gid < 131072; gid += NGT) {
            const int bh = gid >> 13, e = gid & 8191, v = e >> 6, k2 = (e & 63) * 2;
            f32x2 s = {0.f, 0.f};
            unsigned* base = (unsigned*)(SSTB + ((size_t)bh * 128 * 128 + v) * 128 + k2);
            const float* dbase = DK + (size_t)bh * 128 * 128 + k2;
#pragma unroll 1
            for (int c0 = 0; c0 < 128; c0 += 8) {
                unsigned tw[8]; f32x2 dd[8];
#pragma unroll
                for (int u = 0; u < 8; ++u) { tw[u] = base[(size_t)(c0 + u) * 8192]; dd[u] = *(const f32x2*)(dbase + (size_t)(c0 + u) * 128); }
#pragma unroll
                for (int u = 0; u < 8; ++u) { base[(size_t)(c0 + u) * 8192] = pk2(s.x, s.y); s = dd[u] * s + (f32x2){bflo(tw[u]), bfhi(tw[u])}; }
            }
        }
    PHASE_END

    PHASE_BEGIN
        __syncthreads();
        {
            LAS unsigned char* QT = lds; LAS unsigned char* AI = lds + 17408; LAS unsigned char* VS = lds + 2 * 17408; LAS unsigned char* BI = lds + 3 * 17408;
            LAS unsigned char* SC = BI + 160 * HP * 2; LAS float* EX = (LAS float*)(SC + 8 * 2304); LAS float* SSQ = EX + 1024;
            const int k = tid & 127, I = tid >> 7;
            const int fr = lane & 15, fq = lane >> 4;
            const int wI = wave & 3, vh = wave >> 2;
            for (int unit = bid; unit < 2048; unit += G) {
                const int c = unit & 127, bh = unit >> 7, h = bh & 7, b = bh >> 3;
                const size_t row0 = (size_t)b * SEQ + c * 64;
                const int chn = h * 128 + k;
                const float l0 = p.lb_logits[chn], l1 = p.lb_logits[1024 + chn], l2 = p.lb_logits[2048 + chn];
                bf16_t fzr[16], qr[16];
#pragma unroll
                for (int i = 0; i < 16; ++i) { fzr[i] = BIG[(row0 + 16 * I + i) * INC + 3072 + chn]; qr[i] = BIG[(row0 + 16 * I + i) * INC + 2048 + chn]; }
                u32x4 vst[2];
#pragma unroll
                for (int i = 0; i < 2; ++i) { const int idx = tid + 512 * i, r = idx >> 4, ch = idx & 15; vst[i] = *(const u32x4*)(BIG + (row0 + r) * INC + 4096 + h * 128 + 8 * ch); }
                bf16x8 sin[4][4];
#pragma unroll
                for (int kq = 0; kq < 4; ++kq)
#pragma unroll
                    for (int vt = 0; vt < 4; ++vt) sin[kq][vt] = *(const bf16x8*)(SSTB + ((size_t)unit * 128 + 64 * vh + 16 * vt + fr) * 128 + 32 * kq + 8 * fq);
                const size_t orow = row0 + 16 * wI + fr;
                u32x2 graw[4]; f32x4 gnv[4];
#pragma unroll
                for (int vt = 0; vt < 4; ++vt) { const int v = 64 * vh + 16 * vt + 4 * fq; graw[vt] = *(const u32x2*)(BIG + orow * INC + 5120 + h * 128 + v); gnv[vt] = *(const f32x4*)(p.g_norm + h * 128 + v); }
                __builtin_amdgcn_sched_barrier(0);
                float lb; { const float mxl = fmaxf(l0, fmaxf(l1, l2)); const float e0 = __expf(l0 - mxl), e1 = __expf(l1 - mxl), e2 = __expf(l2 - mxl); lb = e0 / (e0 + e1 + e2); }
                float lf[16], kk[16]; float tot = 0.f;
#pragma unroll
                for (int i = 0; i < 16; ++i) { const float fz = bf2f(fzr[i]); const float sg = sigmoidf_(fz); lf[i] = __logf(lb + (1.0f - lb) * sg); kk[i] = (1.0f - lb) * __builtin_amdgcn_rcpf(1.0f + __expf(fz)); tot += lf[i]; }
                __syncthreads();
                EX[I * 128 + k] = tot; EX[512 + I * 128 + k] = lf[0];
#pragma unroll
                for (int i = 0; i < 2; ++i) { const int idx = tid + 512 * i, r = idx >> 4, ch = idx & 15; *(LAS u32x4*)(VS + (r * HP + 8 * ch) * 2) = vst[i]; }
                __syncthreads();
                float bref[4]; float prefix = 0.f;
                { float run = 0.f;
#pragma unroll
                  for (int ii = 0; ii < 4; ++ii) { bref[ii] = run + EX[512 + ii * 128 + k]; if (ii == I) prefix = run; run += EX[ii * 128 + k]; } }
                float brefI = bref[0];
#pragma unroll
                for (int ii = 1; ii < 4; ++ii) if (ii == I) brefI = bref[ii];
                float bc = prefix;
#pragma unroll
                for (int i = 0; i < 16; ++i) {
                    bc += lf[i];
                    const int t = 16 * I + i;
                    const float qs = siluf_(bf2f(qr[i]));
                    *(LAS bf16_t*)(QT + (t * HP + k) * 2) = (bf16_t)(pk2(qs * __expf(bc), 0.f) & 0xffffu);
                    *(LAS bf16_t*)(AI + (t * HP + k) * 2) = (bf16_t)(pk2(qs * __expf(bc - brefI), 0.f) & 0xffffu);
#pragma unroll
                    for (int ii = 0; ii < 4; ++ii) if (ii >= I) { const int offB = 8 * ii * (ii + 1); *(LAS bf16_t*)(BI + ((offB + t) * HP + k) * 2) = (bf16_t)(pk2(kk[i] * __expf(bref[ii] - bc), 0.f) & 0xffffu); }
                }
                __syncthreads();
                LAS unsigned char* SCw = SC + wave * 2304;
                const int offBI = 8 * wI * (wI + 1);
#pragma unroll
                for (int J = 0; J < 4; ++J) {
                    u32x2 w = {0u, 0u};
                    if (J <= wI) {
                        f32x4 sacc = {0.f, 0.f, 0.f, 0.f};
#pragma unroll
                        for (int kq = 0; kq < 4; ++kq) {
                            const bf16x8 a = *(const LAS bf16x8*)(BI + ((offBI + 16 * J + fr) * HP + 32 * kq + 8 * fq) * 2);
                            const bf16x8 bq = *(const LAS bf16x8*)(AI + ((16 * wI + fr) * HP + 32 * kq + 8 * fq) * 2);
                            sacc = __builtin_amdgcn_mfma_f32_16x16x32_bf16(a, bq, sacc, 0, 0, 0);
                        }
#pragma unroll
                        for (int j = 0; j < 4; ++j) if (16 * J + 4 * fq + j > 16 * wI + fr) sacc[j] = 0.f;
                        w.x = pk2(sacc[0], sacc[1]); w.y = pk2(sacc[2], sacc[3]);
                    }
                    *(LAS u32x2*)(SCw + (fr * 72 + 16 * J + 4 * fq) * 2) = w;
                }
                lds_wait();
                f32x4 o[4];
#pragma unroll
                for (int vt = 0; vt < 4; ++vt) o[vt] = (f32x4){0.f, 0.f, 0.f, 0.f};
#pragma unroll
                for (int kq = 0; kq < 4; ++kq) {
                    const bf16x8 bq = *(const LAS bf16x8*)(QT + ((16 * wI + fr) * HP + 32 * kq + 8 * fq) * 2);
#pragma unroll
                    for (int vt = 0; vt < 4; ++vt) o[vt] = __builtin_amdgcn_mfma_f32_16x16x32_bf16(sin[kq][vt], bq, o[vt], 0, 0, 0);
                }
                const unsigned VSa = lds_addr_of(VS);
#pragma unroll
                for (int k2 = 0; k2 < 2; ++k2) {
                    const bf16x8 bs = *(const LAS bf16x8*)(SCw + (fr * 72 + 32 * k2 + 8 * fq) * 2);
                    const unsigned vb = VSa + (unsigned)(((32 * k2 + 8 * fq + (fr >> 2)) * HP + 64 * vh + 4 * (fr & 3)) * 2);
                    s16x4 ra[8];
                    TR8B(ra, vb, 0);
#pragma unroll
                    for (int vt = 0; vt < 4; ++vt) o[vt] = __builtin_amdgcn_mfma_f32_16x16x32_bf16(cat8(ra[2 * vt], ra[2 * vt + 1]), bs, o[vt], 0, 0, 0);
                }
                float ssq = 0.f;
#pragma unroll
                for (int vt = 0; vt < 4; ++vt) ssq += (o[vt][0] * o[vt][0] + o[vt][1] * o[vt][1]) + (o[vt][2] * o[vt][2] + o[vt][3] * o[vt][3]);
                ssq += __shfl_xor(ssq, 16); ssq += __shfl_xor(ssq, 32);
                if (fq == 0) SSQ[vh * 64 + 16 * wI + fr] = ssq;
                __syncthreads();
                const float rstd = 1.0f / sqrtf((SSQ[16 * wI + fr] + SSQ[64 + 16 * wI + fr]) * (1.0f / 128.0f) + 1e-6f);
#pragma unroll
                for (int vt = 0; vt < 4; ++vt) {
                    const int v = 64 * vh + 16 * vt + 4 * fq;
                    const float g0 = siluf_(bflo(graw[vt].x)), g1 = siluf_(bfhi(graw[vt].x)), g2 = siluf_(bflo(graw[vt].y)), g3 = siluf_(bfhi(graw[vt].y));
                    u32x2 w; w.x = pk2(o[vt][0] * rstd * gnv[vt][0] * g0, o[vt][1] * rstd * gnv[vt][1] * g1); w.y = pk2(o[vt][2] * rstd * gnv[vt][2] * g2, o[vt][3] * rstd * gnv[vt][3] * g3);
                    *(u32x2*)(XN + orow * DM + 1024 + h * 128 + v) = w;
                }
            }
            __syncthreads();
        }
        int lane4; asm volatile("v_mbcnt_lo_u32_b32 %0, -1, 0\n\tv_mbcnt_hi_u32_b32 %0, -1, %0" : "=v"(lane4));
        const int gt4 = bid * 512 + wave * 64 + lane4;
        for (int gid = gt4; gid < 131072; gid += NGT) {
            const int ch = gid & 1023, cidx = gid >> 10, chunk = cidx & 63, b = cidx >> 6;
            float hst = 0.f;
#pragma unroll 1
            for (int cc0 = 0; cc0 < chunk; cc0 += 8) {
                f32x2 ag[8];
#pragma unroll
                for (int u = 0; u < 8; ++u) { const int cc = (cc0 + u < 63) ? cc0 + u : 63; ag[u] = AGG[(b * 64 + cc) * 1024 + ch]; }
#pragma unroll
                for (int u = 0; u < 8; ++u) if (cc0 + u < chunk) hst = ag[u].x * hst + ag[u].y;
            }
            const unsigned* src = LAU + (size_t)cidx * 128 * 1024 + ch;
            const size_t trow = (size_t)cidx * 128;
#pragma unroll 1
            for (int t0 = 0; t0 < 128; t0 += 16) {
                unsigned w[16]; bf16_t yv[16];
#pragma unroll
                for (int u = 0; u < 16; ++u) { w[u] = src[(size_t)(t0 + u) * 1024]; yv[u] = BIG[(trow + t0 + u) * INC + 1024 + ch]; }
#pragma unroll
                for (int u = 0; u < 16; ++u) {
                    hst = __expf(bflo(w[u])) * hst + bfhi(w[u]);
                    XN[(trow + t0 + u) * DM + ch] = (bf16_t)(pk2(hst * gelu_tanh(bf2f(yv[u])), 0.f) & 0xffffu);
                }
            }
        }
        transpose_job(p.w_qkv, DM, INC, WA, -1, p.norm_mix + DM, lds, gw, NGW, wave, lane4);
        for (int idx = gt4; idx < NTOK * 16; idx += NGT) {
            const int row = idx >> 4, i = idx & 15;
            const float invf = exp2f(-(float)i * (18.931568569324174f / 16.0f));
            const float ang = (float)p.pos[row] * invf;
            const double rev = (double)ang * 0.15915494309189535;
            const float fr_ = (float)(rev - __builtin_rint(rev));
            TAB[(size_t)idx * 2] = __builtin_amdgcn_cosf(fr_); TAB[(size_t)idx * 2 + 1] = __builtin_amdgcn_sinf(fr_);
        }
    PHASE_END

    PHASE_BEGIN
        pg8::Gemm g{XN, WB, DM, DM, DM, 0, 0}; pg8::Order S; S.init(NTOK, DM, 1, G, bid);
        pg8::EpiResidB<true> E{p.x, nullptr, HB, SSQP};
        pg8::gemm_phase(lds, g, S, E, tid);
    PHASE_END

    PHASE_BEGIN
        pg8::Gemm g{HB, W1, DM, DM, DM, 0, 0}; pg8::Order S; S.init(NTOK, DFF, 1, G, bid);
        fill_rstd_table(RT, SSQP, S, tid);
        pg8::EpiBf16<1, true> E{BIG, DFF, RT};
        pg8::gemm_phase(lds, g, S, E, tid);
    PHASE_END

    PHASE_BEGIN
        pg8::Gemm g{BIG, W2, DFF, DFF, DFF, 0, 0}; pg8::Order S; S.init(NTOK, DM, 1, G, bid);
        pg8::EpiResidB<false> E{nullptr, HB, HB, SSQP};
        pg8::gemm_phase(lds, g, S, E, tid);
    PHASE_END

    PHASE_BEGIN
        pg8::Gemm g{HB, WA, DM, DM, DM, 0, 0}; pg8::Order S; S.init(NTOK, INC, 1, G, bid);
        fill_rstd_table(RT, SSQP, S, tid);
        pg8::EpiQkv E{BIG, TAB, RT};
        pg8::gemm_phase(lds, g, S, E, tid);
    PHASE_END

    PHASE_BEGIN
        LAS unsigned char* KS = lds + wave * (2 * 32 * HP * 2); LAS unsigned char* VS = KS + 32 * HP * 2;
        for (int it = 0; it * G < 1024; ++it) {
            const int item = (G == 256) ? ((bid & 7) * 128 + it * 32 + (bid >> 3)) : (bid + it * G);
            if (item >= 1024) break;
            const int b = item >> 9, h = (item >> 5) & 15, n = item & 31;
            const int r0 = wave, r1 = wave + 8;
            QTile t0, t1;
            const int fr_ = lane & 15;
            {
                const int pc0 = 32 * wave + fr_, pc1 = pc0 + 16;
                attn_tile_init(t0, BIG, b, h, n, 0, lane); attn_tile_init(t1, BIG, b, h, n, 0, lane);
                attn_q_load(t0, BIG, (size_t)b * SEQ + 256 * n + pc0, h, lane); attn_q_load(t1, BIG, (size_t)b * SEQ + 256 * n + pc1, h, lane);
                int g = 0;
                while (g < 12 && 256 * n - 128 + 32 * g + 31 < 0) ++g;
                const int kidx = tid >> 4, ch = tid & 15;
                u32x4 rk, rv;
                { int mk = 256 * n - 128 + 32 * g + kidx; mk = mk < 0 ? 0 : mk; const size_t row = (size_t)b * SEQ + mk;
                  rk = *(const u32x4*)(BIG + row * INC + 2048 + h * 128 + 8 * ch); rv = *(const u32x4*)(BIG + row * INC + 4096 + h * 128 + 8 * ch); }
                __syncthreads();
                int buf = 0;
#pragma unroll 1
                for (; g < 12; ++g) {
                    const int mk0 = 256 * n - 128 + 32 * g;
                    LAS unsigned char* SK = lds + buf * 17408; LAS unsigned char* SV = SK + 8704;
                    *(LAS u32x4*)(SK + (kidx * HP + 8 * ch) * 2) = rk; *(LAS u32x4*)(SV + (kidx * HP + 8 * ch) * 2) = rv;
                    __syncthreads();
                    if (g + 1 < 12) { const size_t row = (size_t)b * SEQ + (mk0 + 32 + kidx);
                        rk = *(const u32x4*)(BIG + row * INC + 2048 + h * 128 + 8 * ch); rv = *(const u32x4*)(BIG + row * INC + 4096 + h * 128 + 8 * ch); }
                    if (g >= wave && g <= wave + 4) attn_pair_update(t0, 256 * n + pc0, t1, 256 * n + pc1, mk0, lds_addr_of(SV), SK, lane);
                    buf ^= 1;
                }
                __syncthreads();
                attn_dump(t0, lds, pc0, lane); attn_dump(t1, lds, pc1, lane);
                __syncthreads();
                attn_pick(t0, lds, 16 * fr_ + r0, lane); attn_pick(t1, lds, 16 * fr_ + r1, lane);
                attn_q_load(t0, BIG, (size_t)b * SEQ + 256 * n + 16 * fr_ + r0, h, lane); attn_q_load(t1, BIG, (size_t)b * SEQ + 256 * n + 16 * fr_ + r1, h, lane);
                __syncthreads();
            }
            attn_branch<true, true>(BIG, b, h, n, 2, wave & 3, 64 * n - 128, 6, t0, r0, t1, r1, KS, VS, lane);
            attn_branch<true, false>(BIG, b, h, n, 4, r0, 16 * n - 144, 5, t0, r0, t1, r1, KS, VS, lane);
            attn_branch<false, true>(BIG, b, h, n, 4, r1, 16 * n - 144, 5, t0, r0, t1, r1, KS, VS, lane);
            attn_tile_store(t0, XN, b, h, n, r0, lane); attn_tile_store(t1, XN, b, h, n, r1, lane);
        }
        __syncthreads();
        int lane3; asm volatile("v_mbcnt_lo_u32_b32 %0, -1, 0\n\tv_mbcnt_hi_u32_b32 %0, -1, %0" : "=v"(lane3));
        transpose_job(p.w_o, DM, DM, WB, -1, nullptr, lds, gw, NGW, wave, lane3);
        transpose_job(p.w1 + (size_t)DM * DFF, DM, DFF, W1, -1, p.norm_mlp + DM, lds, gw, NGW, wave, lane3);
        transpose_job(p.w2 + (size_t)DM * DFF, DFF, DM, W2, -1, nullptr, lds, gw, NGW, wave, lane3);
    PHASE_END

    PHASE_BEGIN
        pg8::Gemm g{XN, WB, DM, DM, DM, 0, 0}; pg8::Order S; S.init(NTOK, DM, 1, G, bid);
        pg8::EpiResidB<false> E{nullptr, HB, HB, SSQP};
        pg8::gemm_phase(lds, g, S, E, tid);
    PHASE_END

    PHASE_BEGIN
        pg8::Gemm g{HB, W1, DM, DM, DM, 0, 0}; pg8::Order S; S.init(NTOK, DFF, 1, G, bid);
        fill_rstd_table(RT, SSQP, S, tid);
        pg8::EpiBf16<1, true> E{BIG, DFF, RT};
        pg8::gemm_phase(lds, g, S, E, tid);
    PHASE_END

    PHASE_BEGIN
        pg8::Gemm g{BIG, W2, DFF, DFF, DFF, 0, 0}; pg8::Order S; S.init(NTOK, DM, 1, G, bid);
        pg8::EpiResidB<false> E{nullptr, HB, HB, nullptr};
        pg8::gemm_phase(lds, g, S, E, tid);
    PHASE_END

    PHASE_BEGIN
        norm_rows_from_bf16<true>(HB, p.final_norm, nullptr, p.out, gw, NGW, lane);
    PHASE_END
#undef PHASE_BEGIN
#undef PHASE_END
}
constexpr int N_PHASES = 14;

extern "C" void kernel_launch(void* const* d_in, const int* in_sizes, int n_in, void* d_out, int out_size, void* d_ws, size_t ws_size, hipStream_t stream) {
    static int grid = 0;
    if (grid == 0) {
        if (n_in != 20 || ws_size < WS_END) { fprintf(stderr, "kernel_launch: unexpected n_in %d / ws_size %zu\n", n_in, ws_size); grid = -1; return; }
        int dev = 0, cus = 0, per_cu = 0;
        hipGetDevice(&dev);
        hipDeviceGetAttribute(&cus, hipDeviceAttributeMultiprocessorCount, dev);
        if (hipFuncSetAttribute((const void*)mega, hipFuncAttributeMaxDynamicSharedMemorySize, LDS_BYTES) != hipSuccess) { fprintf(stderr, "kernel_launch: hipFuncSetAttribute failed\n"); grid = -1; return; }
        if (hipOccupancyMaxActiveBlocksPerMultiprocessor(&per_cu, (const void*)mega, 512, LDS_BYTES) != hipSuccess || per_cu < 1) { fprintf(stderr, "kernel_launch: occupancy query says %d\n", per_cu); per_cu = 1; }
        (void)hipGetLastError();
        grid = cus * 1;
    }
    if (grid < 0) return;
    Params p{};
    p.x = (const float*)d_in[0]; p.pos = (const int*)d_in[1]; p.norm_mix = (const float*)d_in[2]; p.norm_mlp = (const float*)d_in[3]; p.final_norm = (const float*)d_in[4];
    p.w_in = (const float*)d_in[5]; p.conv_w = (const float*)d_in[6]; p.conv_b = (const float*)d_in[7]; p.w_a = (const float*)d_in[8]; p.b_a = (const float*)d_in[9];
    p.w_i = (const float*)d_in[10]; p.b_i = (const float*)d_in[11]; p.lam = (const float*)d_in[12]; p.lb_logits = (const float*)d_in[13]; p.g_norm = (const float*)d_in[14];
    p.w_out = (const float*)d_in[15]; p.w_qkv = (const float*)d_in[16]; p.w_o = (const float*)d_in[17]; p.w1 = (const float*)d_in[18]; p.w2 = (const float*)d_in[19];
    p.out = (float*)d_out; p.ws = (unsigned char*)d_ws;
    if (hipMemsetAsync((unsigned char*)d_ws + WS_CTR, 0, 256, stream) != hipSuccess) { fprintf(stderr, "kernel_launch: memset of the barrier word failed\n"); return; }
    int lo = 0, hi = N_PHASES;
    void* args[] = {&p, &lo, &hi};
    hipError_t e = hipLaunchCooperativeKernel((const void*)mega, dim3(grid), dim3(512), args, LDS_BYTES, stream);
    if (e != hipSuccess) fprintf(stderr, "kernel_launch: cooperative launch failed: %s (grid %d)\n", hipGetErrorString(e), grid);
}
```

```cpp
#include <hip/hip_runtime.h>
#include <hip/hip_cooperative_groups.h>
#include <cstdio>
namespace cg = cooperative_groups;

#define LAS __attribute__((address_space(3)))
typedef unsigned short bf16_t;
typedef short bf16x8 __attribute__((ext_vector_type(8)));
typedef short s16x4 __attribute__((ext_vector_type(4)));
typedef float f32x4 __attribute__((ext_vector_type(4)));
typedef float f32x2 __attribute__((ext_vector_type(2)));
typedef unsigned u32x4 __attribute__((ext_vector_type(4)));
typedef unsigned u32x2 __attribute__((ext_vector_type(2)));

constexpr int SEQ = 8192, NTOK = 16384, DM = 2048, DFF = 8192, INC = 6144;
constexpr int LDS_BYTES = 144 * 1024;
constexpr size_t MiB = 1024 * 1024;
constexpr size_t WS_WA = 0, WS_WB = 24 * MiB, WS_W1 = 32 * MiB, WS_W2 = 64 * MiB, WS_WG = 96 * MiB;
constexpr size_t WS_AGG = 97 * MiB, WS_DK = 98 * MiB, WS_CTR = 99 * MiB, WS_TAB = 100 * MiB;
constexpr size_t WS_XN = 104 * MiB, WS_BIG = 168 * MiB, WS_LA = WS_BIG + 192 * MiB, WS_LU = 424 * MiB, WS_END = 488 * MiB;

struct Params {
    const float* x; const int* pos; const float* norm_mix; const float* norm_mlp; const float* final_norm;
    const float* w_in; const float* conv_w; const float* conv_b; const float* w_a; const float* b_a; const float* w_i; const float* b_i;
    const float* lam; const float* lb_logits; const float* g_norm; const float* w_out; const float* w_qkv; const float* w_o; const float* w1; const float* w2;
    float* out; unsigned char* ws;
};

typedef __bf16 bf16v2_t __attribute__((ext_vector_type(2)));
__device__ __forceinline__ unsigned pk2(float lo, float hi) { bf16v2_t v; v[0] = (__bf16)lo; v[1] = (__bf16)hi; return __builtin_bit_cast(unsigned, v); }
__device__ __forceinline__ float bf2f(bf16_t b) { return __uint_as_float(((unsigned)b) << 16); }
__device__ __forceinline__ float bflo(unsigned w) { return __uint_as_float(w << 16); }
__device__ __forceinline__ float bfhi(unsigned w) { return __uint_as_float(w & 0xffff0000u); }
__device__ __forceinline__ float sigmoidf_(float x) { return __builtin_amdgcn_rcpf(1.0f + __expf(-x)); }
__device__ __forceinline__ float siluf_(float x) { return x * __builtin_amdgcn_rcpf(1.0f + __expf(-x)); }
__device__ __forceinline__ float gelu_tanh(float y) { const float z = 0.7978845608028654f * (y + 0.044715f * y * y * y); const float t = 1.0f - 2.0f / (__expf(2.0f * z) + 1.0f); return 0.5f * y * (1.0f + t); }
__device__ __forceinline__ float wave_sum(float v) {
#pragma unroll
    for (int o = 1; o < 64; o <<= 1) v += __shfl_xor(v, o);
    return v;
}
__device__ __forceinline__ void lds_wait() { asm volatile("s_waitcnt lgkmcnt(0)" ::: "memory"); }
__device__ __forceinline__ s16x4 tr_read(unsigned lds_addr) { s16x4 r; asm volatile("ds_read_b64_tr_b16 %0, %1\n\ts_waitcnt lgkmcnt(0)" : "=&v"(r) : "v"(lds_addr) : "memory"); return r; }
__device__ __forceinline__ bf16x8 cat8(s16x4 a, s16x4 b) { bf16x8 r; r[0] = a[0]; r[1] = a[1]; r[2] = a[2]; r[3] = a[3]; r[4] = b[0]; r[5] = b[1]; r[6] = b[2]; r[7] = b[3]; return r; }
__device__ __forceinline__ bf16x8 pack8(f32x4 a, f32x4 b) { u32x4 w; w.x = pk2(a[0], a[1]); w.y = pk2(a[2], a[3]); w.z = pk2(b[0], b[1]); w.w = pk2(b[2], b[3]); return __builtin_bit_cast(bf16x8, w); }
__device__ __forceinline__ unsigned lds_addr_of(LAS unsigned char* p) { return (unsigned)(size_t)p; }

namespace pg8 {
constexpr int BM = 256, BK = 64, HALF = 128, HTB = HALF * BK * 2, STAGE_BYTES = 8 * HTB, NXCD = 8, WGM = 4;
__device__ __forceinline__ int lds_byte(int r, int c) { const int st = (r >> 4) * 2 + (c >> 5), rr = r & 15, cc = c & 31, ob = rr * 64 + cc * 2; return st * 1024 + (ob ^ (((ob >> 9) & 1) << 5)); }
__device__ __forceinline__ void stage_rc(int b, int& R, int& C) { const int st = b / 1024, sb = b % 1024, swz = sb ^ (((sb >> 9) & 1) << 5); R = (st >> 1) * 16 + swz / 64; C = (st & 1) * 32 + (swz % 64) / 2; }
__device__ __forceinline__ int perm32(int rho) { const int n = rho >> 4, i = rho & 15; return 8 * (i >> 2) + 4 * n + (i & 3); }

struct Unit { int pm, pn, z, i; };
struct Gemm { const bf16_t* A; const bf16_t* Bt; int lda, ldb, K; size_t a_z, b_z; };
struct Order {
    int nM, nN, nZ, per, G, c;
    __device__ void init(int M, int N, int Z, int G_, int c_) { nM = M / BM; nN = N / BM; nZ = Z; per = nM * nN; G = G_; c = c_; }
    __device__ bool next(int i, Unit& u) const {
        const long L = (long)i * G + c; if (L >= (long)per * nZ) return false;
        const int nwg = per * nZ;
        int wgid = (int)L; { const int q = nwg / NXCD, r = nwg % NXCD, xcd = wgid % NXCD, off = wgid / NXCD; wgid = (xcd < r ? xcd * (q + 1) : r * (q + 1) + (xcd - r) * q) + off; }
        u.z = wgid / per; wgid -= u.z * per;
        const int nig = WGM * nN, gid = wgid / nig, fm = gid * WGM, gsz = (nM - fm) < WGM ? (nM - fm) : WGM;
        u.pm = fm + ((wgid % nig) % gsz); u.pn = (wgid % nig) / gsz; u.i = i; return true;
    }
};

template <class Epi>
__device__ __forceinline__ void gemm_phase(LAS unsigned char* lds, const Gemm g, const Order& S, const Epi& E, const int tid) {
    const int wid = __builtin_amdgcn_readfirstlane(tid >> 6), lane = tid & 63, wr = wid >> 2, wc = wid & 3, fr = lane & 15, fq = lane >> 4;
    const int K = g.K, nt = K / BK;
    unsigned voffA[2], voffB[2];
#pragma unroll
    for (int i = 0; i < 2; ++i) { int R, C; stage_rc(tid * 16 + i * 8192, R, C); const int Rb = Epi::PERM ? ((R & ~31) + perm32(R & 31)) : R;
        voffA[i] = (unsigned)(R * g.lda + C) * 2u; voffB[i] = (unsigned)(Rb * g.ldb + C) * 2u; }
    const size_t kstep = (size_t)(BK * 2);
    const size_t hstepA = (size_t)HALF * g.lda * 2, hstepB = (size_t)HALF * g.ldb * 2;
    const size_t tstepA = 2 * hstepA, tstepB = 2 * hstepB;
    const unsigned ldsw = (unsigned)wid * 1024u;
    const int aoff = lds_byte(wr * 64 + fr, fq * 8), boff = lds_byte(wc * 32 + fr, fq * 8);
#define PG8_SA(b, h) (((b) * 2 + (h)) * HTB)
#define PG8_SB(b, h) ((4 + (b) * 2 + (h)) * HTB)
#define PG8_STAGE(bufoff, gbase, voff) do { _Pragma("unroll") for (int _i = 0; _i < 2; ++_i) \
        __builtin_amdgcn_global_load_lds((const unsigned*)((const char*)(gbase) + (voff)[_i]), (LAS unsigned*)(lds + (bufoff) + ldsw + _i * 8192), 16, 0, 0); } while (0)
#define PG8_LDA(dst, b, h) do { _Pragma("unroll") for (int m = 0; m < 4; ++m) _Pragma("unroll") for (int k = 0; k < 2; ++k) dst[m][k] = *(const LAS bf16x8*)(lds + PG8_SA(b, h) + aoff + m * 2048 + k * 1024); } while (0)
#define PG8_LDB(dst, b, h) do { _Pragma("unroll") for (int n = 0; n < 2; ++n) _Pragma("unroll") for (int k = 0; k < 2; ++k) dst[n][k] = *(const LAS bf16x8*)(lds + PG8_SB(b, h) + boff + n * 2048 + k * 1024); } while (0)
#define PG8_MMA(ai, bj, At, Bt) do { __builtin_amdgcn_s_setprio(1); _Pragma("unroll") for (int m = 0; m < 4; ++m) _Pragma("unroll") for (int n = 0; n < 2; ++n) _Pragma("unroll") for (int k = 0; k < 2; ++k) \
        acc[ai][bj][m][n] = __builtin_amdgcn_mfma_f32_16x16x32_bf16(Bt[n][k], At[m][k], acc[ai][bj][m][n], 0, 0, 0); __builtin_amdgcn_s_setprio(0); } while (0)
#define PG8_WAIT_V(n) asm volatile("s_waitcnt vmcnt(" #n ")" ::: "memory")
#define PG8_WAIT_L(n) asm volatile("s_waitcnt lgkmcnt(" #n ")" ::: "memory")
#define PG8_BAR __builtin_amdgcn_s_barrier()
#define PG8_SCHED __builtin_amdgcn_sched_barrier(0)
    Unit cur, nxt; int ui = 0;
    if (!S.next(0, cur)) return;
    f32x4 acc[2][2][4][2];
#pragma unroll
    for (int a = 0; a < 2; ++a)
#pragma unroll
        for (int b = 0; b < 2; ++b)
#pragma unroll
            for (int m = 0; m < 4; ++m)
#pragma unroll
                for (int n = 0; n < 2; ++n) acc[a][b][m][n] = (f32x4){0.f, 0.f, 0.f, 0.f};
    bf16x8 At[4][2], B0[2][2], B1[2][2];
    const char* cA = (const char*)g.A + (size_t)cur.pm * tstepA + (size_t)cur.z * g.a_z; const char* cB = (const char*)g.Bt + (size_t)cur.pn * tstepB + (size_t)cur.z * g.b_z;
    PG8_STAGE(PG8_SB(0, 0), cB, voffB); PG8_STAGE(PG8_SA(0, 0), cA, voffA); PG8_STAGE(PG8_SB(0, 1), cB + hstepB, voffB); PG8_STAGE(PG8_SA(0, 1), cA + hstepA, voffA);
    if (wr == 1) PG8_BAR;
    PG8_WAIT_V(4); PG8_BAR;
    PG8_STAGE(PG8_SB(1, 0), cB + kstep, voffB); PG8_STAGE(PG8_SA(1, 0), cA + kstep, voffA); PG8_STAGE(PG8_SB(1, 1), cB + hstepB + kstep, voffB);
    PG8_WAIT_V(6); PG8_BAR;
    for (;;) {
        const bool has_next = S.next(ui + 1, nxt);
        const char* nA = has_next ? (const char*)g.A + (size_t)nxt.pm * tstepA + (size_t)nxt.z * g.a_z : cA; const char* nB = has_next ? (const char*)g.Bt + (size_t)nxt.pn * tstepB + (size_t)nxt.z * g.b_z : cB;
        for (int t = 0; t < nt; t += 2) {
            const bool last = (t == nt - 2);
            const char* a1 = cA + (size_t)(t + 1) * kstep;
            const char* a2 = last ? nA : cA + (size_t)(t + 2) * kstep; const char* b2 = last ? nB : cB + (size_t)(t + 2) * kstep;
            const char* a3 = a2 + kstep; const char* b3 = b2 + kstep;
            PG8_LDB(B0, 0, 0); PG8_SCHED; PG8_LDA(At, 0, 0); PG8_STAGE(PG8_SA(1, 1), a1 + hstepA, voffA);
            PG8_WAIT_L(8); PG8_BAR; PG8_WAIT_L(0); PG8_MMA(0, 0, At, B0); PG8_BAR; PG8_SCHED;
            PG8_LDB(B1, 0, 1); PG8_STAGE(PG8_SB(0, 0), b2, voffB);
            PG8_BAR; PG8_WAIT_L(0); PG8_MMA(0, 1, At, B1); PG8_BAR;
            PG8_LDA(At, 0, 1); PG8_STAGE(PG8_SA(0, 0), a2, voffA);
            PG8_BAR; PG8_WAIT_L(0); PG8_MMA(1, 0, At, B0); PG8_BAR; PG8_SCHED;
            PG8_STAGE(PG8_SB(0, 1), b2 + hstepB, voffB);
            PG8_WAIT_V(6); PG8_BAR; PG8_MMA(1, 1, At, B1); PG8_BAR;
            PG8_LDB(B0, 1, 0); PG8_SCHED; PG8_LDA(At, 1, 0); PG8_STAGE(PG8_SA(0, 1), a2 + hstepA, voffA);
            PG8_WAIT_L(8); PG8_BAR; PG8_WAIT_L(0); PG8_MMA(0, 0, At, B0); PG8_BAR; PG8_SCHED;
            PG8_LDB(B1, 1, 1); PG8_STAGE(PG8_SB(1, 0), b3, voffB);
            PG8_BAR; PG8_WAIT_L(0); PG8_MMA(0, 1, At, B1); PG8_BAR;
            PG8_LDA(At, 1, 1); PG8_STAGE(PG8_SA(1, 0), a3, voffA);
            PG8_BAR; PG8_WAIT_L(0); PG8_MMA(1, 0, At, B0); PG8_BAR; PG8_SCHED;
            PG8_STAGE(PG8_SB(1, 1), b3 + hstepB, voffB);
            PG8_WAIT_V(6); PG8_BAR; PG8_MMA(1, 1, At, B1); PG8_BAR;
        }
        E(acc, cur, wr, wc, fr, fq);
        if (!has_next) break;
#pragma unroll
        for (int a = 0; a < 2; ++a)
#pragma unroll
            for (int b = 0; b < 2; ++b)
#pragma unroll
                for (int m = 0; m < 4; ++m)
#pragma unroll
                    for (int n = 0; n < 2; ++n) acc[a][b][m][n] = (f32x4){0.f, 0.f, 0.f, 0.f};
        cur = nxt; cA = nA; cB = nB; ++ui;
    }
    PG8_WAIT_V(0);
    if (wr == 0) PG8_BAR;
    PG8_BAR;
#undef PG8_SA
#undef PG8_SB
#undef PG8_STAGE
#undef PG8_LDA
#undef PG8_LDB
#undef PG8_MMA
#undef PG8_WAIT_V
#undef PG8_WAIT_L
#undef PG8_BAR
#undef PG8_SCHED
}

template <int ACT  , bool RS = false> struct EpiBf16 {
    static constexpr bool PERM = true;
    bf16_t* O; int ldc; const LAS float* rt;
    __device__ __forceinline__ void operator()(const f32x4 (&acc)[2][2][4][2], const Unit& u, int wr, int wc, int fr, int fq) const {
        const int row0 = u.pm * BM + wr * 64 + fr, col0 = u.pn * BM + wc * 32 + 8 * fq;
#pragma unroll
        for (int ai = 0; ai < 2; ++ai)
#pragma unroll
            for (int m = 0; m < 4; ++m) { bf16_t* rowp = O + (size_t)(row0 + ai * HALF + m * 16) * ldc + col0;
                float rs = 1.0f; if (RS) rs = rt[u.i * 256 + wr * 64 + fr + ai * HALF + m * 16];
#pragma unroll
                for (int bj = 0; bj < 2; ++bj) { f32x4 v0 = acc[ai][bj][m][0], v1 = acc[ai][bj][m][1];
                    if (RS) { v0 *= rs; v1 *= rs; }
                    if (ACT == 1) {
#pragma unroll
                        for (int j = 0; j < 4; ++j) { const float a = fmaxf(v0[j], 0.f), b = fmaxf(v1[j], 0.f); v0[j] = a * a; v1[j] = b * b; } }
                    u32x4 w; w.x = pk2(v0[0], v0[1]); w.y = pk2(v0[2], v0[3]); w.z = pk2(v1[0], v1[1]); w.w = pk2(v1[2], v1[3]);
                    *(u32x4*)(rowp + bj * HALF) = w; } }
    }
};
template <bool BASE_F32> struct EpiResidB {
    static constexpr bool PERM = true;
    const float* basef; const bf16_t* baseb; bf16_t* out; float* ssqp;
    __device__ __forceinline__ void operator()(const f32x4 (&acc)[2][2][4][2], const Unit& u, int wr, int wc, int fr, int fq) const {
        const int row0 = u.pm * BM + wr * 64 + fr, col0 = u.pn * BM + wc * 32 + 8 * fq;
#pragma unroll
        for (int ai = 0; ai < 2; ++ai) {
            if (BASE_F32) {
#pragma unroll
                for (int m = 0; m < 4; m += 2) {
                    f32x4 bs[2][2][2];
#pragma unroll
                    for (int mm = 0; mm < 2; ++mm) { const size_t off = (size_t)(row0 + ai * HALF + (m + mm) * 16) * DM + col0;
#pragma unroll
                        for (int bj = 0; bj < 2; ++bj)
#pragma unroll
                            for (int n = 0; n < 2; ++n) bs[mm][bj][n] = *(const f32x4*)(basef + off + bj * HALF + n * 4); }
#pragma unroll
                    for (int mm = 0; mm < 2; ++mm) { const size_t off = (size_t)(row0 + ai * HALF + (m + mm) * 16) * DM + col0;
                        float ss = 0.f;
#pragma unroll
                        for (int bj = 0; bj < 2; ++bj) { const f32x4 v0 = bs[mm][bj][0] + acc[ai][bj][m + mm][0], v1 = bs[mm][bj][1] + acc[ai][bj][m + mm][1];
                            ss += (v0[0] * v0[0] + v0[1] * v0[1]) + (v0[2] * v0[2] + v0[3] * v0[3]) + (v1[0] * v1[0] + v1[1] * v1[1]) + (v1[2] * v1[2] + v1[3] * v1[3]);
                            u32x4 w; w.x = pk2(v0[0], v0[1]); w.y = pk2(v0[2], v0[3]); w.z = pk2(v1[0], v1[1]); w.w = pk2(v1[2], v1[3]);
                            *(u32x4*)(out + off + bj * HALF) = w; }
                        if (ssqp) { ss += __shfl_xor(ss, 16); ss += __shfl_xor(ss, 32); if (fq == 0) ssqp[(size_t)(row0 + ai * HALF + (m + mm) * 16) * 32 + u.pn * 4 + wc] = ss; } }
                    asm volatile("" ::: "memory"); }
            } else {
                u32x4 bs[4][2];
#pragma unroll
                for (int m = 0; m < 4; ++m) { const size_t off = (size_t)(row0 + ai * HALF + m * 16) * DM + col0;
#pragma unroll
                    for (int bj = 0; bj < 2; ++bj) bs[m][bj] = *(const u32x4*)(baseb + off + bj * HALF); }
#pragma unroll
                for (int m = 0; m < 4; ++m) { const size_t off = (size_t)(row0 + ai * HALF + m * 16) * DM + col0;
                    float ss = 0.f;
#pragma unroll
                    for (int bj = 0; bj < 2; ++bj) { const u32x4 q = bs[m][bj]; const f32x4 a0 = acc[ai][bj][m][0], a1 = acc[ai][bj][m][1];
                        const float h0 = bflo(q.x) + a0[0], h1 = bfhi(q.x) + a0[1], h2 = bflo(q.y) + a0[2], h3 = bfhi(q.y) + a0[3], h4 = bflo(q.z) + a1[0], h5 = bfhi(q.z) + a1[1], h6 = bflo(q.w) + a1[2], h7 = bfhi(q.w) + a1[3];
                        ss += (h0 * h0 + h1 * h1) + (h2 * h2 + h3 * h3) + (h4 * h4 + h5 * h5) + (h6 * h6 + h7 * h7);
                        u32x4 w; w.x = pk2(h0, h1); w.y = pk2(h2, h3); w.z = pk2(h4, h5); w.w = pk2(h6, h7);
                        *(u32x4*)(out + off + bj * HALF) = w; }
                    if (ssqp) { ss += __shfl_xor(ss, 16); ss += __shfl_xor(ss, 32); if (fq == 0) ssqp[(size_t)(row0 + ai * HALF + m * 16) * 32 + u.pn * 4 + wc] = ss; } }
                asm volatile("" ::: "memory");
            }
        }
    }
};
struct EpiGates {
    static constexpr bool PERM = false;
    const bf16_t* XC; const float* b_a; const float* b_i; const float* spt; unsigned* LAU;
    __device__ __forceinline__ void operator()(const f32x4 (&acc)[2][2][4][2], const Unit& u, int wr, int wc, int fr, int fq) const {
        const int row0 = u.pm * BM + wr * 64 + fr, ch0 = u.z * 256 + u.pn * 128 + wc * 32 + 4 * fq;
#pragma unroll
        for (int n = 0; n < 2; ++n) {
            const int ch = ch0 + 16 * n;
            u32x2 xw[2][4];
#pragma unroll
            for (int ai = 0; ai < 2; ++ai)
#pragma unroll
                for (int m = 0; m < 4; ++m) xw[ai][m] = *(const u32x2*)(XC + (unsigned)(row0 + ai * HALF + m * 16) * 1024u + (unsigned)ch);
            const f32x4 ba = *(const f32x4*)(b_a + ch), bi = *(const f32x4*)(b_i + ch), sp = *(const f32x4*)(spt + ch);
#pragma unroll
            for (int ai = 0; ai < 2; ++ai)
#pragma unroll
                for (int m = 0; m < 4; ++m) {
                    const unsigned off = (unsigned)(row0 + ai * HALF + m * 16) * 1024u + (unsigned)ch;
                    const float xc[4] = {bflo(xw[ai][m].x), bfhi(xw[ai][m].x), bflo(xw[ai][m].y), bfhi(xw[ai][m].y)};
                    u32x4 w;
#pragma unroll
                    for (int j = 0; j < 4; ++j) {
                        const float r = sigmoidf_(acc[ai][0][m][n][j] + ba[j]), ig = sigmoidf_(acc[ai][1][m][n][j] + bi[j]);
                        const float la = sp[j] * r, x2 = 2.0f * la;
                        const float ser = -x2 * (1.0f + x2 * (0.5f + x2 * (0.16666667f + x2 * (0.041666668f + x2 * 0.0083333338f))));
                        const float om = (x2 > -0.25f) ? ser : (1.0f - __expf(x2));
                        w[j] = pk2(la, __builtin_amdgcn_sqrtf(om) * ig * xc[j]);
                    }
                    *(u32x4*)(LAU + off) = w;
                }
        }
    }
};
struct EpiQkv {
    static constexpr bool PERM = false;
    bf16_t* O; const float* tab; const LAS float* rt;
    __device__ __forceinline__ void operator()(f32x4 (&acc)[2][2][4][2], const Unit& u, int wr, int wc, int fr, int fq) const {
        const int row0 = u.pm * BM + wr * 64 + fr, col0 = u.pn * BM + wc * 32 + 4 * fq;
        const int sec = u.pn >> 3;
        const float scale = (sec == 0) ? 0.08838834764831845f : 1.0f;
#pragma unroll
        for (int ai = 0; ai < 2; ++ai)
#pragma unroll
            for (int m = 0; m < 4; ++m) {
                const int row = row0 + ai * HALF + m * 16;
                if (sec < 2 && wc == 0) {
                    const f32x4 t0 = *(const f32x4*)(tab + (size_t)row * 32 + 8 * fq), t1 = *(const f32x4*)(tab + (size_t)row * 32 + 8 * fq + 4);
                    const float cs[4] = {t0[0], t0[2], t1[0], t1[2]}, sn[4] = {t0[1], t0[3], t1[1], t1[3]};
#pragma unroll
                    for (int bj = 0; bj < 2; ++bj)
#pragma unroll
                        for (int j = 0; j < 4; ++j) { const float a = acc[ai][bj][m][0][j], b = acc[ai][bj][m][1][j];
                            acc[ai][bj][m][0][j] = a * cs[j] - b * sn[j]; acc[ai][bj][m][1][j] = b * cs[j] + a * sn[j]; }
                }
                bf16_t* rowp = O + (size_t)row * INC + col0;
#pragma unroll
                for (int bj = 0; bj < 2; ++bj)
#pragma unroll
                    for (int n = 0; n < 2; ++n) { const f32x4 v = acc[ai][bj][m][n] * (scale * rt[u.i * 256 + wr * 64 + fr + ai * HALF + m * 16]); u32x2 w; w.x = pk2(v[0], v[1]); w.y = pk2(v[2], v[3]); *(u32x2*)(rowp + bj * HALF + n * 16) = w; }
            }
    }
};
}

__device__ __forceinline__ void transpose_item(const float* W, int K, int N, bf16_t* WT, int gate, const float* kscale, LAS float* scr, int item, int lane) {
    const int nblk = N / 64, kb = item / nblk, nb = item % nblk, k0 = 64 * kb, n0 = 64 * nb;
    const int c4 = (lane & 15) * 4, kr = lane >> 4;
    f32x4 v[16];
#pragma unroll
    for (int i = 0; i < 16; ++i) v[i] = __builtin_nontemporal_load((const f32x4*)(W + (size_t)(k0 + 4 * i + kr) * N + n0 + c4));
#pragma unroll
    for (int i = 0; i < 16; ++i) { LAS float* d = scr + (4 * i + kr) * 65 + c4; d[0] = v[i][0]; d[1] = v[i][1]; d[2] = v[i][2]; d[3] = v[i][3]; }
    lds_wait();
    const int c = lane & 7;
    f32x4 k0v = {1.f, 1.f, 1.f, 1.f}, k1v = k0v;
    if (kscale) { k0v = *(const f32x4*)(kscale + k0 + 8 * c); k1v = *(const f32x4*)(kscale + k0 + 8 * c + 4); }
#pragma unroll
    for (int j = 0; j < 8; ++j) { const int n = (lane >> 3) + 8 * j; const LAS float* s = scr + (8 * c) * 65 + n;
        u32x4 o; o.x = pk2(s[0 * 65] * k0v[0], s[1 * 65] * k0v[1]); o.y = pk2(s[2 * 65] * k0v[2], s[3 * 65] * k0v[3]); o.z = pk2(s[4 * 65] * k1v[0], s[5 * 65] * k1v[1]); o.w = pk2(s[6 * 65] * k1v[2], s[7 * 65] * k1v[3]);
        const int nn = n0 + n; const int row = gate < 0 ? nn : (256 * (nn >> 7) + 128 * gate + (nn & 127));
        *(u32x4*)(WT + (size_t)row * K + k0 + 8 * c) = o; }
    lds_wait();
}
__device__ __forceinline__ void transpose_job(const float* W, int K, int N, bf16_t* WT, int gate, const float* kscale, LAS unsigned char* lds, int gw, int NGW, int wave, int lane) {
    LAS float* scr = (LAS float*)(lds + wave * 16640);
    const int items = (K / 64) * (N / 64);
    for (int it = gw; it < items; it += NGW) transpose_item(W, K, N, WT, gate, kscale, scr, it, lane);
}
__device__ __forceinline__ void norm_rows_bf16(const float* X, const float* gain, bf16_t* O, int gw, int NGW, int lane) {
    for (int m = gw; m < NTOK; m += NGW) {
        const f32x4* xr = (const f32x4*)(X + (size_t)m * DM) + lane;
        f32x4 v[8]; float s = 0.f;
#pragma unroll
        for (int j = 0; j < 8; ++j) { v[j] = __builtin_nontemporal_load(xr + 64 * j); s += (v[j].x * v[j].x + v[j].y * v[j].y) + (v[j].z * v[j].z + v[j].w * v[j].w); }
        const float rstd = 1.0f / sqrtf(wave_sum(s) * (1.0f / DM) + 1e-6f);
        u32x2* o8 = (u32x2*)(O + (size_t)m * DM) + lane;
#pragma unroll
        for (int j = 0; j < 8; ++j) { const f32x4 g = ((const f32x4*)gain)[lane + 64 * j]; u32x2 w; w.x = pk2(v[j].x * rstd * g.x, v[j].y * rstd * g.y); w.y = pk2(v[j].z * rstd * g.z, v[j].w * rstd * g.w); o8[64 * j] = w; }
    }
}
template <bool OUT_F32>
__device__ __forceinline__ void norm_rows_from_bf16(const bf16_t* H, const float* gain, bf16_t* OB, float* OF, int gw, int NGW, int lane) {
    for (int m = gw; m < NTOK; m += NGW) {
        const u32x4* hr = (const u32x4*)(H + (size_t)m * DM) + lane;
        u32x4 q[4]; float v[4][8]; float s = 0.f;
#pragma unroll
        for (int j = 0; j < 4; ++j) q[j] = __builtin_nontemporal_load(hr + 64 * j);
#pragma unroll
        for (int j = 0; j < 4; ++j) { v[j][0] = bflo(q[j].x); v[j][1] = bfhi(q[j].x); v[j][2] = bflo(q[j].y); v[j][3] = bfhi(q[j].y); v[j][4] = bflo(q[j].z); v[j][5] = bfhi(q[j].z); v[j][6] = bflo(q[j].w); v[j][7] = bfhi(q[j].w);
#pragma unroll
            for (int e = 0; e < 8; ++e) s += v[j][e] * v[j][e]; }
        const float rstd = 1.0f / sqrtf(wave_sum(s) * (1.0f / DM) + 1e-6f);
#pragma unroll
        for (int j = 0; j < 4; ++j) {
            const int c0 = 8 * (lane + 64 * j);
            const f32x4 g0 = *(const f32x4*)(gain + c0), g1 = *(const f32x4*)(gain + c0 + 4);
            const float o0 = v[j][0] * rstd * g0[0], o1 = v[j][1] * rstd * g0[1], o2 = v[j][2] * rstd * g0[2], o3 = v[j][3] * rstd * g0[3];
            const float o4 = v[j][4] * rstd * g1[0], o5 = v[j][5] * rstd * g1[1], o6 = v[j][6] * rstd * g1[2], o7 = v[j][7] * rstd * g1[3];
            if (OUT_F32) { float* op = OF + (size_t)m * DM + c0; __builtin_nontemporal_store((f32x4){o0, o1, o2, o3}, (f32x4*)op); __builtin_nontemporal_store((f32x4){o4, o5, o6, o7}, (f32x4*)(op + 4)); }
            else { u32x4 w; w.x = pk2(o0, o1); w.y = pk2(o2, o3); w.z = pk2(o4, o5); w.w = pk2(o6, o7); *(u32x4*)(OB + (size_t)m * DM + c0) = w; }
        }
    }
}
__device__ __forceinline__ void norm_rows_f32_inplace(float* X, const float* gain, int gw, int NGW, int lane) {
    for (int m = gw; m < NTOK; m += NGW) {
        f32x4* xr = (f32x4*)(X + (size_t)m * DM) + lane;
        f32x4 v[8]; float s = 0.f;
#pragma unroll
        for (int j = 0; j < 8; ++j) { v[j] = xr[64 * j]; s += (v[j].x * v[j].x + v[j].y * v[j].y) + (v[j].z * v[j].z + v[j].w * v[j].w); }
        const float rstd = 1.0f / sqrtf(wave_sum(s) * (1.0f / DM) + 1e-6f);
#pragma unroll
        for (int j = 0; j < 8; ++j) { const f32x4 g = ((const f32x4*)gain)[lane + 64 * j]; xr[64 * j] = v[j] * rstd * g; }
    }
}

constexpr int HP = 136;
__device__ __forceinline__ bf16x8 tr_frag(unsigned base, int rowbase, int col0, int lane) {
    const int g = lane >> 4, idx = lane & 15, q = idx >> 2, p = idx & 3;
    const unsigned a0 = base + (unsigned)(((rowbase + 8 * g + q) * HP + col0 + 4 * p) * 2);
    const s16x4 lo = tr_read(a0), hi = tr_read(a0 + 4 * HP * 2);
    return cat8(lo, hi);
}

struct QTile { bf16x8 q[4]; f32x4 o[8]; float m, l; };
struct KVRegs { u32x4 k[8], v[8]; };

#define TR8(r, base, o0) asm volatile( \
    "ds_read_b64_tr_b16 %0, %8 offset:" #o0 "+0\n\tds_read_b64_tr_b16 %1, %8 offset:" #o0 "+4352\n\t" \
    "ds_read_b64_tr_b16 %2, %8 offset:" #o0 "+32\n\tds_read_b64_tr_b16 %3, %8 offset:" #o0 "+4384\n\t" \
    "ds_read_b64_tr_b16 %4, %8 offset:" #o0 "+64\n\tds_read_b64_tr_b16 %5, %8 offset:" #o0 "+4416\n\t" \
    "ds_read_b64_tr_b16 %6, %8 offset:" #o0 "+96\n\tds_read_b64_tr_b16 %7, %8 offset:" #o0 "+4448\n\t" \
    "s_waitcnt lgkmcnt(0)" \
    : "=&v"(r[0]), "=&v"(r[1]), "=&v"(r[2]), "=&v"(r[3]), "=&v"(r[4]), "=&v"(r[5]), "=&v"(r[6]), "=&v"(r[7]) : "v"(base) : "memory")

#define TR8B(r, base, o0) asm volatile( \
    "ds_read_b64_tr_b16 %0, %8 offset:" #o0 "+0\n\tds_read_b64_tr_b16 %1, %8 offset:" #o0 "+1088\n\t" \
    "ds_read_b64_tr_b16 %2, %8 offset:" #o0 "+32\n\tds_read_b64_tr_b16 %3, %8 offset:" #o0 "+1120\n\t" \
    "ds_read_b64_tr_b16 %4, %8 offset:" #o0 "+64\n\tds_read_b64_tr_b16 %5, %8 offset:" #o0 "+1152\n\t" \
    "ds_read_b64_tr_b16 %6, %8 offset:" #o0 "+96\n\tds_read_b64_tr_b16 %7, %8 offset:" #o0 "+1184\n\t" \
    "s_waitcnt lgkmcnt(0)" \
    : "=&v"(r[0]), "=&v"(r[1]), "=&v"(r[2]), "=&v"(r[3]), "=&v"(r[4]), "=&v"(r[5]), "=&v"(r[6]), "=&v"(r[7]) : "v"(base) : "memory")

__device__ __forceinline__ void attn_tile_update(QTile& t, const int mq, int mk0, unsigned VSa, LAS unsigned char* KS, int lane) {
    const int fr = lane & 15, fq = lane >> 4;
    f32x4 s0 = {0.f, 0.f, 0.f, 0.f}, s1 = {0.f, 0.f, 0.f, 0.f};
#pragma unroll
    for (int kk = 0; kk < 4; ++kk) {
        const bf16x8 a0 = *(const LAS bf16x8*)(KS + ((fr)*HP + 32 * kk + 8 * fq) * 2);
        const bf16x8 a1 = *(const LAS bf16x8*)(KS + ((16 + fr) * HP + 32 * kk + 8 * fq) * 2);
        s0 = __builtin_amdgcn_mfma_f32_16x16x32_bf16(a0, t.q[kk], s0, 0, 0, 0);
        s1 = __builtin_amdgcn_mfma_f32_16x16x32_bf16(a1, t.q[kk], s1, 0, 0, 0);
    }
    const float NEG = -__builtin_inff();
    float mx = NEG;
    bool v0[4], v1[4];
#pragma unroll
    for (int j = 0; j < 4; ++j) {
        const int mk = mk0 + 4 * fq + j, jd = mq - mk;
        v0[j] = (jd >= 0) && (jd <= 128) && (mk >= 0);
        v1[j] = (jd - 16 >= 0) && (jd - 16 <= 128) && (mk + 16 >= 0);
        if (v0[j]) mx = fmaxf(mx, s0[j]);
        if (v1[j]) mx = fmaxf(mx, s1[j]);
    }
    mx = fmaxf(mx, __shfl_xor(mx, 16)); mx = fmaxf(mx, __shfl_xor(mx, 32));
    const float mnew = fmaxf(t.m, mx);
    const float muse = (mnew == NEG) ? 0.f : mnew;
    const float alpha = __expf(t.m - muse);
    f32x4 p0, p1; float ps = 0.f;
#pragma unroll
    for (int j = 0; j < 4; ++j) { p0[j] = v0[j] ? __expf(s0[j] - muse) : 0.f; p1[j] = v1[j] ? __expf(s1[j] - muse) : 0.f; ps += p0[j] + p1[j]; }
    t.l = t.l * alpha + ps; t.m = mnew;
#pragma unroll
    for (int dt = 0; dt < 8; ++dt) t.o[dt] *= alpha;
    const bf16x8 pf = pack8(p0, p1);
    const unsigned vb = VSa + (unsigned)(((4 * fq + (fr >> 2)) * HP + 4 * (fr & 3)) * 2);
    s16x4 ra[8], rb[8];
    TR8(ra, vb, 0);
    TR8(rb, vb, 128);
#pragma unroll
    for (int dt = 0; dt < 4; ++dt) t.o[dt] = __builtin_amdgcn_mfma_f32_16x16x32_bf16(cat8(ra[2 * dt], ra[2 * dt + 1]), pf, t.o[dt], 0, 0, 0);
#pragma unroll
    for (int dt = 0; dt < 4; ++dt) t.o[4 + dt] = __builtin_amdgcn_mfma_f32_16x16x32_bf16(cat8(rb[2 * dt], rb[2 * dt + 1]), pf, t.o[4 + dt], 0, 0, 0);
}

__device__ __forceinline__ void attn_pair_update(QTile& t0, const int mq0, QTile& t1, const int mq1, int mk0, unsigned VSa, LAS unsigned char* KS, int lane) {
    const int fr = lane & 15, fq = lane >> 4;
    f32x4 s00 = {0.f, 0.f, 0.f, 0.f}, s01 = s00, s10 = s00, s11 = s00;
#pragma unroll
    for (int kk = 0; kk < 4; ++kk) {
        const bf16x8 a0 = *(const LAS bf16x8*)(KS + ((fr)*HP + 32 * kk + 8 * fq) * 2);
        const bf16x8 a1 = *(const LAS bf16x8*)(KS + ((16 + fr) * HP + 32 * kk + 8 * fq) * 2);
        s00 = __builtin_amdgcn_mfma_f32_16x16x32_bf16(a0, t0.q[kk], s00, 0, 0, 0);
        s01 = __builtin_amdgcn_mfma_f32_16x16x32_bf16(a1, t0.q[kk], s01, 0, 0, 0);
        s10 = __builtin_amdgcn_mfma_f32_16x16x32_bf16(a0, t1.q[kk], s10, 0, 0, 0);
        s11 = __builtin_amdgcn_mfma_f32_16x16x32_bf16(a1, t1.q[kk], s11, 0, 0, 0);
    }
    const float NEG = -__builtin_inff();
    float mx0 = NEG, mx1 = NEG;
#pragma unroll
    for (int j = 0; j < 4; ++j) {
        const int mk = mk0 + 4 * fq + j, jd0 = mq0 - mk, jd1 = mq1 - mk;
        const bool kv0 = (mk >= 0), kv1 = (mk + 16 >= 0);
        if (!((jd0 >= 0) && (jd0 <= 128) && kv0)) s00[j] = NEG;
        if (!((jd0 - 16 >= 0) && (jd0 - 16 <= 128) && kv1)) s01[j] = NEG;
        if (!((jd1 >= 0) && (jd1 <= 128) && kv0)) s10[j] = NEG;
        if (!((jd1 - 16 >= 0) && (jd1 - 16 <= 128) && kv1)) s11[j] = NEG;
        mx0 = fmaxf(mx0, fmaxf(s00[j], s01[j])); mx1 = fmaxf(mx1, fmaxf(s10[j], s11[j]));
    }
    { const float a = __shfl_xor(mx0, 16), b = __shfl_xor(mx1, 16); mx0 = fmaxf(mx0, a); mx1 = fmaxf(mx1, b); }
    { const float a = __shfl_xor(mx0, 32), b = __shfl_xor(mx1, 32); mx0 = fmaxf(mx0, a); mx1 = fmaxf(mx1, b); }
    const float mn0 = fmaxf(t0.m, mx0), mn1 = fmaxf(t1.m, mx1);
    const float mu0 = (mn0 == NEG) ? 0.f : mn0, mu1 = (mn1 == NEG) ? 0.f : mn1;
    const float al0 = __expf(t0.m - mu0), al1 = __expf(t1.m - mu1);
    f32x4 p00, p01, p10, p11; float ps0 = 0.f, ps1 = 0.f;
#pragma unroll
    for (int j = 0; j < 4; ++j) {
        p00[j] = __expf(s00[j] - mu0); p01[j] = __expf(s01[j] - mu0); p10[j] = __expf(s10[j] - mu1); p11[j] = __expf(s11[j] - mu1);
        ps0 += p00[j] + p01[j]; ps1 += p10[j] + p11[j];
    }
    t0.l = t0.l * al0 + ps0; t0.m = mn0; t1.l = t1.l * al1 + ps1; t1.m = mn1;
#pragma unroll
    for (int dt = 0; dt < 8; ++dt) { t0.o[dt] *= al0; t1.o[dt] *= al1; }
    const bf16x8 pf0 = pack8(p00, p01), pf1 = pack8(p10, p11);
    const unsigned vb = VSa + (unsigned)(((4 * fq + (fr >> 2)) * HP + 4 * (fr & 3)) * 2);
    s16x4 ra[8];
    TR8(ra, vb, 0);
#pragma unroll
    for (int dt = 0; dt < 4; ++dt) { const bf16x8 vf = cat8(ra[2 * dt], ra[2 * dt + 1]);
        t0.o[dt] = __builtin_amdgcn_mfma_f32_16x16x32_bf16(vf, pf0, t0.o[dt], 0, 0, 0); t1.o[dt] = __builtin_amdgcn_mfma_f32_16x16x32_bf16(vf, pf1, t1.o[dt], 0, 0, 0); }
    s16x4 rb[8];
    TR8(rb, vb, 128);
#pragma unroll
    for (int dt = 0; dt < 4; ++dt) { const bf16x8 vf = cat8(rb[2 * dt], rb[2 * dt + 1]);
        t0.o[4 + dt] = __builtin_amdgcn_mfma_f32_16x16x32_bf16(vf, pf0, t0.o[4 + dt], 0, 0, 0); t1.o[4 + dt] = __builtin_amdgcn_mfma_f32_16x16x32_bf16(vf, pf1, t1.o[4 + dt], 0, 0, 0); }
}

__device__ __forceinline__ void attn_load(KVRegs& R, const bf16_t* QKV, int b, int h, int dsh, int rd, int mk0, int lane) {
#pragma unroll
    for (int it = 0; it < 8; ++it) {
        const int kidx = 4 * it + (lane >> 4), ch = lane & 15;
        int mk = mk0 + kidx; mk = mk < 0 ? 0 : mk;
        const size_t row = (size_t)b * SEQ + ((size_t)mk << dsh) + rd;
        R.k[it] = *(const u32x4*)(QKV + row * INC + 2048 + h * 128 + 8 * ch);
        R.v[it] = *(const u32x4*)(QKV + row * INC + 4096 + h * 128 + 8 * ch);
    }
}
__device__ __forceinline__ void attn_stage(const KVRegs& R, LAS unsigned char* KS, LAS unsigned char* VS, int lane) {
#pragma unroll
    for (int it = 0; it < 8; ++it) {
        const int kidx = 4 * it + (lane >> 4), ch = lane & 15;
        *(LAS u32x4*)(KS + (kidx * HP + 8 * ch) * 2) = R.k[it];
        *(LAS u32x4*)(VS + (kidx * HP + 8 * ch) * 2) = R.v[it];
    }
    lds_wait();
}
template <bool T0, bool T1>
__device__ __forceinline__ void attn_branch(const bf16_t* QKV, int b, int h, int n, int dsh, int rd, int mkbase, int ng, QTile& t0, int r0, QTile& t1, int r1, LAS unsigned char* KS, LAS unsigned char* VS, int lane) {
    int g = 0;
    while (g < ng && mkbase + 32 * g + 31 < 0) ++g;
    if (g >= ng) return;
    KVRegs R;
    attn_load(R, QKV, b, h, dsh, rd, mkbase + 32 * g, lane);
    const unsigned VSa = lds_addr_of(VS);
#pragma unroll 1
    for (; g < ng; ++g) {
        const int mk0 = mkbase + 32 * g;
        attn_stage(R, KS, VS, lane);
        if (g + 1 < ng) attn_load(R, QKV, b, h, dsh, rd, mk0 + 32, lane);
        const int mqa = (256 * n + 16 * (lane & 15) + r0 - rd) >> dsh, mqb = (256 * n + 16 * (lane & 15) + r1 - rd) >> dsh;
        if (T0 && T1) attn_pair_update(t0, mqa, t1, mqb, mk0, VSa, KS, lane);
        else if (T0) attn_tile_update(t0, mqa, mk0, VSa, KS, lane);
        else attn_tile_update(t1, mqb, mk0, VSa, KS, lane);
        lds_wait();
    }
}

__device__ __forceinline__ void attn_tile_init(QTile& t, const bf16_t* QKV, int b, int h, int n, int r, int lane) {
    const int fr = lane & 15, fq = lane >> 4;
    const size_t row = (size_t)b * SEQ + 256 * n + 16 * fr + r;
#pragma unroll
    for (int kk = 0; kk < 4; ++kk) t.q[kk] = *(const bf16x8*)(QKV + row * INC + h * 128 + 32 * kk + 8 * fq);
#pragma unroll
    for (int dt = 0; dt < 8; ++dt) t.o[dt] = (f32x4){0.f, 0.f, 0.f, 0.f};
    t.m = -__builtin_inff(); t.l = 0.f;
}
__device__ __forceinline__ unsigned ex_off(int p, int dt, int fq) { return (unsigned)(p * 528 + ((dt ^ ((p >> 4) & 7)) * 64) + fq * 16); }
__device__ __forceinline__ void attn_q_load(QTile& t, const bf16_t* QKV, size_t row, int h, int lane) {
    const int fq = lane >> 4;
#pragma unroll
    for (int kk = 0; kk < 4; ++kk) t.q[kk] = *(const bf16x8*)(QKV + row * INC + h * 128 + 32 * kk + 8 * fq);
}
__device__ __forceinline__ void attn_dump(QTile& t, LAS unsigned char* lds, int p, int lane) {
    asm volatile("" : "+v"(p));
    const int fq = lane >> 4;
    float l = t.l; l += __shfl_xor(l, 16); l += __shfl_xor(l, 32);
#pragma unroll
    for (int dt = 0; dt < 8; ++dt) *(LAS f32x4*)(lds + ex_off(p, dt, fq)) = t.o[dt];
    if (fq == 0) *(LAS f32x2*)(lds + 135168 + p * 8) = (f32x2){t.m, l};
}
__device__ __forceinline__ void attn_pick(QTile& t, LAS unsigned char* lds, int p, int lane) {
    asm volatile("" : "+v"(p));
    const int fq = lane >> 4;
#pragma unroll
    for (int dt = 0; dt < 8; ++dt) t.o[dt] = *(const LAS f32x4*)(lds + ex_off(p, dt, fq));
    const f32x2 ml = *(const LAS f32x2*)(lds + 135168 + p * 8);
    t.m = ml.x; t.l = ml.y * 0.25f;
}
__device__ __forceinline__ void attn_tile_store(QTile& t, bf16_t* ATT, int b, int h, int n, int r, int lane) {
    const int fr = lane & 15, fq = lane >> 4;
    float l = t.l; l += __shfl_xor(l, 16); l += __shfl_xor(l, 32);
    const float inv = 1.0f / l;
    const size_t row = (size_t)b * SEQ + 256 * n + 16 * fr + r;
#pragma unroll
    for (int dt = 0; dt < 8; ++dt) { const f32x4 v = t.o[dt] * inv; u32x2 w; w.x = pk2(v[0], v[1]); w.y = pk2(v[2], v[3]); *(u32x2*)(ATT + row * DM + h * 128 + 16 * dt + 4 * fq) = w; }
}

__device__ __forceinline__ void fill_rstd_table(LAS float* RT, const float* SSQP, const pg8::Order& S, int tid) {
    pg8::Unit uu;
    for (int i = 0; S.next(i, uu); ++i) {
        if (tid < 256) {
            const f32x4* pp = (const f32x4*)(SSQP + (size_t)(uu.pm * 256 + tid) * 32);
            float sacc = 0.f;
#pragma unroll
            for (int q = 0; q < 8; ++q) { const f32x4 v = pp[q]; sacc += (v[0] + v[1]) + (v[2] + v[3]); }
            RT[i * 256 + tid] = 1.0f / sqrtf(sacc * (1.0f / DM) + 1e-6f);
        }
    }
    __syncthreads();
}

__device__ __forceinline__ void grid_barrier(unsigned* ctr, unsigned target, int wave) {
    int lane; asm volatile("v_mbcnt_lo_u32_b32 %0, -1, 0\n\tv_mbcnt_hi_u32_b32 %0, -1, %0" : "=v"(lane));
    asm volatile("s_waitcnt vmcnt(0) lgkmcnt(0)" ::: "memory");
    __syncthreads();
    if (wave == 0) {
        __builtin_amdgcn_fence(__ATOMIC_RELEASE, "agent");
        if (lane == 0) {
            __hip_atomic_fetch_add(ctr, 1u, __ATOMIC_RELAXED, __HIP_MEMORY_SCOPE_AGENT);
            while (__hip_atomic_load(ctr, __ATOMIC_RELAXED, __HIP_MEMORY_SCOPE_AGENT) < target) __builtin_amdgcn_s_sleep(4);
        }
        __builtin_amdgcn_fence(__ATOMIC_ACQUIRE, "agent");
        asm volatile("s_waitcnt vmcnt(0)" ::: "memory");
    }
    __syncthreads();
}

__global__ void __launch_bounds__(512, 2) mega(Params p, int ph_lo, int ph_hi) {
    extern __shared__ __attribute__((aligned(16))) unsigned char lds_raw[];
    LAS unsigned char* lds = (LAS unsigned char*)lds_raw;
    cg::grid_group grid = cg::this_grid();
    const int wave = __builtin_amdgcn_readfirstlane(threadIdx.x >> 6);
    const int G = gridDim.x, bid = blockIdx.x;
    const int gw = bid * 8 + wave, NGW = G * 8;
    const int NGT = G * 512;
    unsigned char* ws = p.ws;
    bf16_t* WA = (bf16_t*)(ws + WS_WA); bf16_t* WB = (bf16_t*)(ws + WS_WB); bf16_t* W1 = (bf16_t*)(ws + WS_W1); bf16_t* W2 = (bf16_t*)(ws + WS_W2); bf16_t* WG = (bf16_t*)(ws + WS_WG);
    f32x2* AGG = (f32x2*)(ws + WS_AGG); float* DK = (float*)(ws + WS_DK); float* TAB = (float*)(ws + WS_TAB);
    bf16_t* XN = (bf16_t*)(ws + WS_XN); bf16_t* BIG = (bf16_t*)(ws + WS_BIG); float* SSQP = (float*)(ws + WS_TAB + 2 * MiB); LAS float* RT = (LAS float*)(lds + pg8::STAGE_BYTES);
    unsigned* LAU = (unsigned*)(ws + WS_LA); bf16_t* HB = (bf16_t*)(ws + WS_LU);
    bf16_t* SSTB = (bf16_t*)p.out;
    grid.sync();
    int ph = 0, nbar = 0;
    unsigned* CTR = (unsigned*)(ws + WS_CTR); float* SPT = (float*)(ws + WS_CTR + 4096);
#ifndef DUPMASK
#define DUPMASK 0
#endif
#define PHASE_BEGIN if (ph >= ph_lo && ph < ph_hi) { for (int rep = 0; rep <= ((DUPMASK >> ph) & 1); ++rep) { if (ph > ph_lo || rep > 0) { \
        ++nbar; grid_barrier(CTR, (unsigned)nbar * (unsigned)G, wave); } \
    int lane; asm volatile("v_mbcnt_lo_u32_b32 %0, -1, 0\n\tv_mbcnt_hi_u32_b32 %0, -1, %0" : "=v"(lane)); const int tid = wave * 64 + lane; const int gt = bid * 512 + tid; (void)gt;
#define PHASE_END } } ++ph;

    PHASE_BEGIN
        transpose_job(p.w_in, DM, INC, WA, -1, nullptr, lds, gw, NGW, wave, lane);
#pragma unroll 1
        for (int hh = 0; hh < 4; ++hh) {
            transpose_job(p.w_a + (size_t)hh * 65536, 256, 256, WG + (size_t)hh * 131072, 0, nullptr, lds, gw, NGW, wave, lane);
            transpose_job(p.w_i + (size_t)hh * 65536, 256, 256, WG + (size_t)hh * 131072, 1, nullptr, lds, gw, NGW, wave, lane);
        }
        transpose_job(p.w_out, DM, DM, WB, -1, nullptr, lds, gw, NGW, wave, lane);
        transpose_job(p.w1, DM, DFF, W1, -1, p.norm_mlp, lds, gw, NGW, wave, lane);
        transpose_job(p.w2, DFF, DM, W2, -1, nullptr, lds, gw, NGW, wave, lane);
        norm_rows_bf16(p.x, p.norm_mix, XN, gw, NGW, lane);
        if (gt < 1024) SPT[gt] = -8.0f * log1pf(__expf(-p.lam[gt]));
    PHASE_END

    PHASE_BEGIN
        pg8::Gemm g{XN, WA, DM, DM, DM, 0, 0}; pg8::Order S; S.init(NTOK, INC, 1, G, bid);
        pg8::EpiBf16<0> E{BIG, INC, nullptr};
        pg8::gemm_phase(lds, g, S, E, tid);
    PHASE_END

    PHASE_BEGIN
        for (int idx = gt; idx < NTOK * 128; idx += NGT) {
            const int t = idx >> 7, c8 = (idx & 127) * 8, pos = t & (SEQ - 1);
            float a[8];
            { const f32x4 b0 = *(const f32x4*)(p.conv_b + c8), b1 = *(const f32x4*)(p.conv_b + c8 + 4); a[0] = b0[0]; a[1] = b0[1]; a[2] = b0[2]; a[3] = b0[3]; a[4] = b1[0]; a[5] = b1[1]; a[6] = b1[2]; a[7] = b1[3]; }
#pragma unroll
            for (int j = 0; j < 4; ++j) {
                if (pos - 3 + j >= 0) {
                    const u32x4 xw = *(const u32x4*)(BIG + (size_t)(t - 3 + j) * INC + c8);
                    const f32x4 w0 = *(const f32x4*)(p.conv_w + j * 1024 + c8), w1 = *(const f32x4*)(p.conv_w + j * 1024 + c8 + 4);
                    a[0] += w0[0] * bflo(xw.x); a[1] += w0[1] * bfhi(xw.x); a[2] += w0[2] * bflo(xw.y); a[3] += w0[3] * bfhi(xw.y);
                    a[4] += w1[0] * bflo(xw.z); a[5] += w1[1] * bfhi(xw.z); a[6] += w1[2] * bflo(xw.w); a[7] += w1[3] * bfhi(xw.w);
                }
            }
            u32x4 o; o.x = pk2(a[0], a[1]); o.y = pk2(a[2], a[3]); o.z = pk2(a[4], a[5]); o.w = pk2(a[6], a[7]);
            *(u32x4*)(XN + (size_t)t * 1024 + c8) = o;
        }
        {
            LAS unsigned char* KT = lds; LAS unsigned char* VS = lds + 64 * HP * 2; LAS float* EX = (LAS float*)(lds + 2 * 64 * HP * 2);
            const int k = tid & 127, I = tid >> 7;
            const int fr = lane & 15, fq = lane >> 4;
            for (int unit = bid; unit < 2048; unit += G) {
                const int c = unit & 127, bh = unit >> 7, h = bh & 7, b = bh >> 3;
                const size_t row0 = (size_t)b * SEQ + c * 64;
                const int chn = h * 128 + k;
                const float l0 = p.lb_logits[chn], l1 = p.lb_logits[1024 + chn], l2 = p.lb_logits[2048 + chn];
                bf16_t fzr[16];
#pragma unroll
                for (int i = 0; i < 16; ++i) fzr[i] = BIG[(row0 + 16 * I + i) * INC + 3072 + chn];
                u32x4 vst[2];
#pragma unroll
                for (int i = 0; i < 2; ++i) { const int idx = tid + 512 * i, r = idx >> 4, ch = idx & 15; vst[i] = *(const u32x4*)(BIG + (row0 + r) * INC + 4096 + h * 128 + 8 * ch); }
                __builtin_amdgcn_sched_barrier(0);
                float lb; { const float mxl = fmaxf(l0, fmaxf(l1, l2)); const float e0 = __expf(l0 - mxl), e1 = __expf(l1 - mxl), e2 = __expf(l2 - mxl); lb = e0 / (e0 + e1 + e2); }
                float lf[16], kk[16]; float tot = 0.f;
#pragma unroll
                for (int i = 0; i < 16; ++i) { const float fz = bf2f(fzr[i]); const float sg = sigmoidf_(fz); lf[i] = __logf(lb + (1.0f - lb) * sg); kk[i] = (1.0f - lb) * __builtin_amdgcn_rcpf(1.0f + __expf(fz)); tot += lf[i]; }
                __syncthreads();
                EX[I * 128 + k] = tot;
#pragma unroll
                for (int i = 0; i < 2; ++i) { const int idx = tid + 512 * i, r = idx >> 4, ch = idx & 15; *(LAS u32x4*)(VS + (r * HP + 8 * ch) * 2) = vst[i]; }
                __syncthreads();
                float prefix = 0.f, total = 0.f;
#pragma unroll
                for (int ii = 0; ii < 4; ++ii) { const float e = EX[ii * 128 + k]; total += e; if (ii < I) prefix += e; }
                if (I == 0) DK[(size_t)unit * 128 + k] = __expf(total);
                float bc = prefix;
#pragma unroll
                for (int i = 0; i < 16; ++i) { bc += lf[i]; const float kt = kk[i] * __expf(total - bc); *(LAS bf16_t*)(KT + ((16 * I + i) * HP + k) * 2) = (bf16_t)(pk2(kt, 0.f) & 0xffffu); }
                __syncthreads();
                const unsigned KTa = lds_addr_of(KT), VSa = lds_addr_of(VS);
                f32x4 acc[8];
#pragma unroll
                for (int vt = 0; vt < 8; ++vt) acc[vt] = (f32x4){0.f, 0.f, 0.f, 0.f};
#pragma unroll
                for (int k2 = 0; k2 < 2; ++k2) {
                    const bf16x8 a = tr_frag(KTa, 32 * k2, 16 * wave, lane);
                    const unsigned vb = VSa + (unsigned)(((32 * k2 + 8 * fq + (fr >> 2)) * HP + 4 * (fr & 3)) * 2);
                    s16x4 ra[8], rb[8];
                    TR8B(ra, vb, 0); TR8B(rb, vb, 128);
#pragma unroll
                    for (int vt = 0; vt < 4; ++vt) acc[vt] = __builtin_amdgcn_mfma_f32_16x16x32_bf16(a, cat8(ra[2 * vt], ra[2 * vt + 1]), acc[vt], 0, 0, 0);
#pragma unroll
                    for (int vt = 0; vt < 4; ++vt) acc[4 + vt] = __builtin_amdgcn_mfma_f32_16x16x32_bf16(a, cat8(rb[2 * vt], rb[2 * vt + 1]), acc[4 + vt], 0, 0, 0);
                }
#pragma unroll
                for (int vt = 0; vt < 8; ++vt) { u32x2 w; w.x = pk2(acc[vt][0], acc[vt][1]); w.y = pk2(acc[vt][2], acc[vt][3]);
                    *(u32x2*)(SSTB + ((size_t)unit * 128 + 16 * vt + fr) * 128 + 16 * wave + 4 * fq) = w; }
            }
            __syncthreads();
        }
    PHASE_END

    PHASE_BEGIN
        {
            pg8::Gemm g{XN, WG, 1024, 256, 256, (size_t)256 * 2, (size_t)512 * 256 * 2}; pg8::Order S; S.init(NTOK, 512, 4, G, bid);
            pg8::EpiGates E{XN, p.b_a, p.b_i, SPT, LAU};
            pg8::gemm_phase(lds, g, S, E, tid);
        }
        int lane2; asm volatile("v_mbcnt_lo_u32_b32 %0, -1, 0\n\tv_mbcnt_hi_u32_b32 %0, -1, %0" : "=v"(lane2));
        {
            pg8::Order S; S.init(NTOK, 512, 4, G, bid); pg8::Unit uu;
            const int tid2 = wave * 64 + lane2, half = tid2 >> 8, sub = (tid2 >> 7) & 1, chl = tid2 & 127;
            for (int i = 0; S.next(i, uu); ++i) {
                const int ch = uu.z * 256 + uu.pn * 128 + chl, cidx = 2 * uu.pm + half;
                const unsigned* src = LAU + ((size_t)cidx * 128 + 64 * sub) * 1024 + ch;
                float P = 1.f, H = 0.f;
#pragma unroll 16
                for (int t = 0; t < 64; ++t) { const unsigned w = src[(size_t)t * 1024]; const float a = __expf(bflo(w)); H = a * H + bfhi(w); P *= a; }
                LAS float* X2 = (LAS float*)lds;
                if (sub == 1) { X2[(half * 128 + chl) * 2] = P; X2[(half * 128 + chl) * 2 + 1] = H; }
                __syncthreads();
                if (sub == 0) { const float P1 = X2[(half * 128 + chl) * 2], H1 = X2[(half * 128 + chl) * 2 + 1]; AGG[(size_t)cidx * 1024 + ch] = (f32x2){P * P1, P1 * H + H1}; }
                __syncthreads();
            }
        }
        if (rep == 0) for (int gid = bid * 512 + wave * 64 + lane2; gid < 131072; gid += NGT) {
            const int bh = gid >> 13, e = gid & 8191, v = e >> 6, k2 = (e & 63) * 2;
            f32x2 s = {0.f, 0.f};
            unsigned* base = (unsigned*)(SSTB + ((size_t)bh * 128 * 128 + v) * 128 + k2);
            const float* dbase = DK + (size_t)bh * 128 * 128 + k2;
#pragma unroll 1
            for (int c0 = 0; c0 < 128; c0 += 8) {
                unsigned tw[8]; f32x2 dd[8];
#pragma unroll
                for (int u = 0; u < 8; ++u) { tw[u] = base[(size_t)(c0 + u) * 8192]; dd[u] = *(const f32x2*)(dbase + (size_t)(c0 + u) * 128); }
#pragma unroll
                for (int u = 0; u < 8; ++u) { base[(size_t)(c0 + u) * 8192] = pk2(s.x, s.y); s = dd[u] * s + (f32x2){bflo(tw[u]), bfhi(tw[u])}; }
            }
        }
    PHASE_END

    PHASE_BEGIN
        __syncthreads();
        {
            LAS unsigned char* QT = lds; LAS unsigned char* AI = lds + 17408; LAS unsigned char* VS = lds + 2 * 17408; LAS unsigned char* BI = lds + 3 * 17408;
            LAS unsigned char* SC = BI + 160 * HP * 2; LAS float* EX = (LAS float*)(SC + 8 * 2304); LAS float* SSQ = EX + 1024;
            const int k = tid & 127, I = tid >> 7;
            const int fr = lane & 15, fq = lane >> 4;
            const int wI = wave & 3, vh = wave >> 2;
            for (int unit = bid; unit < 2048; unit += G) {
                const int c = unit & 127, bh = unit >> 7, h = bh & 7, b = bh >> 3;
                const size_t row0 = (size_t)b * SEQ + c * 64;
                const int chn = h * 128 + k;
                const float l0 = p.lb_logits[chn], l1 = p.lb_logits[1024 + chn], l2 = p.lb_logits[2048 + chn];
                bf16_t fzr[16], qr[16];
#pragma unroll
                for (int i = 0; i < 16; ++i) { fzr[i] = BIG[(row0 + 16 * I + i) * INC + 3072 + chn]; qr[i] = BIG[(row0 + 16 * I + i) * INC + 2048 + chn]; }
                u32x4 vst[2];
#pragma unroll
                for (int i = 0; i < 2; ++i) { const int idx = tid + 512 * i, r = idx >> 4, ch = idx & 15; vst[i] = *(const u32x4*)(BIG + (row0 + r) * INC + 4096 + h * 128 + 8 * ch); }
                bf16x8 sin[4][4];
#pragma unroll
                for (int kq = 0; kq < 4; ++kq)
#pragma unroll
                    for (int vt = 0; vt < 4; ++vt) sin[kq][vt] = *(const bf16x8*)(SSTB + ((size_t)unit * 128 + 64 * vh + 16 * vt + fr) * 128 + 32 * kq + 8 * fq);
                const size_t orow = row0 + 16 * wI + fr;
                u32x2 graw[4]; f32x4 gnv[4];
#pragma unroll
                for (int vt = 0; vt < 4; ++vt) { const int v = 64 * vh + 16 * vt + 4 * fq; graw[vt] = *(const u32x2*)(BIG + orow * INC + 5120 + h * 128 + v); gnv[vt] = *(const f32x4*)(p.g_norm + h * 128 + v); }
                __builtin_amdgcn_sched_barrier(0);
                float lb; { const float mxl = fmaxf(l0, fmaxf(l1, l2)); const float e0 = __expf(l0 - mxl), e1 = __expf(l1 - mxl), e2 = __expf(l2 - mxl); lb = e0 / (e0 + e1 + e2); }
                float lf[16], kk[16]; float tot = 0.f;
#pragma unroll
                for (int i = 0; i < 16; ++i) { const float fz = bf2f(fzr[i]); const float sg = sigmoidf_(fz); lf[i] = __logf(lb + (1.0f - lb) * sg); kk[i] = (1.0f - lb) * __builtin_amdgcn_rcpf(1.0f + __expf(fz)); tot += lf[i]; }
                __syncthreads();
                EX[I * 128 + k] = tot; EX[512 + I * 128 + k] = lf[0];
#pragma unroll
                for (int i = 0; i < 2; ++i) { const int idx = tid + 512 * i, r = idx >> 4, ch = idx & 15; *(LAS u32x4*)(VS + (r * HP + 8 * ch) * 2) = vst[i]; }
                __syncthreads();
                float bref[4]; float prefix = 0.f;
                { float run = 0.f;
#pragma unroll
                  for (int ii = 0; ii < 4; ++ii) { bref[ii] = run + EX[512 + ii * 128 + k]; if (ii == I) prefix = run; run += EX[ii * 128 + k]; } }
                float brefI = bref[0];
#pragma unroll
                for (int ii = 1; ii < 4; ++ii) if (ii == I) brefI = bref[ii];
                float bc = prefix;
#pragma unroll
                for (int i = 0; i < 16; ++i) {
                    bc += lf[i];
                    const int t = 16 * I + i;
                    const float qs = siluf_(bf2f(qr[i]));
                    *(LAS bf16_t*)(QT + (t * HP + k) * 2) = (bf16_t)(pk2(qs * __expf(bc), 0.f) & 0xffffu);
                    *(LAS bf16_t*)(AI + (t * HP + k) * 2) = (bf16_t)(pk2(qs * __expf(bc - brefI), 0.f) & 0xffffu);
#pragma unroll
                    for (int ii = 0; ii < 4; ++ii) if (ii >= I) { const int offB = 8 * ii * (ii + 1); *(LAS bf16_t*)(BI + ((offB + t) * HP + k) * 2) = (bf16_t)(pk2(kk[i] * __expf(bref[ii] - bc), 0.f) & 0xffffu); }
                }
                __syncthreads();
                LAS unsigned char* SCw = SC + wave * 2304;
                const int offBI = 8 * wI * (wI + 1);
#pragma unroll
                for (int J = 0; J < 4; ++J) {
                    u32x2 w = {0u, 0u};
                    if (J <= wI) {
                        f32x4 sacc = {0.f, 0.f, 0.f, 0.f};
#pragma unroll
                        for (int kq = 0; kq < 4; ++kq) {
                            const bf16x8 a = *(const LAS bf16x8*)(BI + ((offBI + 16 * J + fr) * HP + 32 * kq + 8 * fq) * 2);
                            const bf16x8 bq = *(const LAS bf16x8*)(AI + ((16 * wI + fr) * HP + 32 * kq + 8 * fq) * 2);
                            sacc = __builtin_amdgcn_mfma_f32_16x16x32_bf16(a, bq, sacc, 0, 0, 0);
                        }
#pragma unroll
                        for (int j = 0; j < 4; ++j) if (16 * J + 4 * fq + j > 16 * wI + fr) sacc[j] = 0.f;
                        w.x = pk2(sacc[0], sacc[1]); w.y = pk2(sacc[2], sacc[3]);
                    }
                    *(LAS u32x2*)(SCw + (fr * 72 + 16 * J + 4 * fq) * 2) = w;
                }
                lds_wait();
                f32x4 o[4];
#pragma unroll
                for (int vt = 0; vt < 4; ++vt) o[vt] = (f32x4){0.f, 0.f, 0.f, 0.f};
#pragma unroll
                for (int kq = 0; kq < 4; ++kq) {
                    const bf16x8 bq = *(const LAS bf16x8*)(QT + ((16 * wI + fr) * HP + 32 * kq + 8 * fq) * 2);
#pragma unroll
                    for (int vt = 0; vt < 4; ++vt) o[vt] = __builtin_amdgcn_mfma_f32_16x16x32_bf16(sin[kq][vt], bq, o[vt], 0, 0, 0);
                }
                const unsigned VSa = lds_addr_of(VS);
#pragma unroll
                for (int k2 = 0; k2 < 2; ++k2) {
                    const bf16x8 bs = *(const LAS bf16x8*)(SCw + (fr * 72 + 32 * k2 + 8 * fq) * 2);
                    const unsigned vb = VSa + (unsigned)(((32 * k2 + 8 * fq + (fr >> 2)) * HP + 64 * vh + 4 * (fr & 3)) * 2);
                    s16x4 ra[8];
                    TR8B(ra, vb, 0);
#pragma unroll
                    for (int vt = 0; vt < 4; ++vt) o[vt] = __builtin_amdgcn_mfma_f32_16x16x32_bf16(cat8(ra[2 * vt], ra[2 * vt + 1]), bs, o[vt], 0, 0, 0);
                }
                float ssq = 0.f;
#pragma unroll
                for (int vt = 0; vt < 4; ++vt) ssq += (o[vt][0] * o[vt][0] + o[vt][1] * o[vt][1]) + (o[vt][2] * o[vt][2] + o[vt][3] * o[vt][3]);
                ssq += __shfl_xor(ssq, 16); ssq += __shfl_xor(ssq, 32);
                if (fq == 0) SSQ[vh * 64 + 16 * wI + fr] = ssq;
                __syncthreads();
                const float rstd = 1.0f / sqrtf((SSQ[16 * wI + fr] + SSQ[64 + 16 * wI + fr]) * (1.0f / 128.0f) + 1e-6f);
#pragma unroll
                for (int vt = 0; vt < 4; ++vt) {
                    const int v = 64 * vh + 16 * vt + 4 * fq;
                    const float g0 = siluf_(bflo(graw[vt].x)), g1 = siluf_(bfhi(graw[vt].x)), g2 = siluf_(bflo(graw[vt].y)), g3 = siluf_(bfhi(graw[vt].y));
                    u32x2 w; w.x = pk2(o[vt][0] * rstd * gnv[vt][0] * g0, o[vt][1] * rstd * gnv[vt][1] * g1); w.y = pk2(o[vt][2] * rstd * gnv[vt][2] * g2, o[vt][3] * rstd * gnv[vt][3] * g3);
                    *(u32x2*)(XN + orow * DM + 1024 + h * 128 + v) = w;
                }
            }
            __syncthreads();
        }
        int lane4; asm volatile("v_mbcnt_lo_u32_b32 %0, -1, 0\n\tv_mbcnt_hi_u32_b32 %0, -1, %0" : "=v"(lane4));
        const int gt4 = bid * 512 + wave * 64 + lane4;
        for (int gid = gt4; gid < 131072; gid += NGT) {
            const int ch = gid & 1023, cidx = gid >> 10, chunk = cidx & 63, b = cidx >> 6;
            float hst = 0.f;
#pragma unroll 1
            for (int cc0 = 0; cc0 < chunk; cc0 += 8) {
                f32x2 ag[8];
#pragma unroll
                for (int u = 0; u < 8; ++u) { const int cc = (cc0 + u < 63) ? cc0 + u : 63; ag[u] = AGG[(b * 64 + cc) * 1024 + ch]; }
#pragma unroll
                for (int u = 0; u < 8; ++u) if (cc0 + u < chunk) hst = ag[u].x * hst + ag[u].y;
            }
            const unsigned* src = LAU + (size_t)cidx * 128 * 1024 + ch;
            const size_t trow = (size_t)cidx * 128;
#pragma unroll 1
            for (int t0 = 0; t0 < 128; t0 += 16) {
                unsigned w[16]; bf16_t yv[16];
#pragma unroll
                for (int u = 0; u < 16; ++u) { w[u] = src[(size_t)(t0 + u) * 1024]; yv[u] = BIG[(trow + t0 + u) * INC + 1024 + ch]; }
#pragma unroll
                for (int u = 0; u < 16; ++u) {
                    hst = __expf(bflo(w[u])) * hst + bfhi(w[u]);
                    XN[(trow + t0 + u) * DM + ch] = (bf16_t)(pk2(hst * gelu_tanh(bf2f(yv[u])), 0.f) & 0xffffu);
                }
            }
        }
        transpose_job(p.w_qkv, DM, INC, WA, -1, p.norm_mix + DM, lds, gw, NGW, wave, lane4);
        for (int idx = gt4; idx < NTOK * 16; idx += NGT) {
            const int row = idx >> 4, i = idx & 15;
            const float invf = exp2f(-(float)i * (18.931568569324174f / 16.0f));
            const float ang = (float)p.pos[row] * invf;
            const double rev = (double)ang * 0.15915494309189535;
            const float fr_ = (float)(rev - __builtin_rint(rev));
            TAB[(size_t)idx * 2] = __builtin_amdgcn_cosf(fr_); TAB[(size_t)idx * 2 + 1] = __builtin_amdgcn_sinf(fr_);
        }
    PHASE_END

    PHASE_BEGIN
        pg8::Gemm g{XN, WB, DM, DM, DM, 0, 0}; pg8::Order S; S.init(NTOK, DM, 1, G, bid);
        pg8::EpiResidB<true> E{p.x, nullptr, HB, SSQP};
        pg8::gemm_phase(lds, g, S, E, tid);
    PHASE_END

    PHASE_BEGIN
        pg8::Gemm g{HB, W1, DM, DM, DM, 0, 0}; pg8::Order S; S.init(NTOK, DFF, 1, G, bid);
        fill_rstd_table(RT, SSQP, S, tid);
        pg8::EpiBf16<1, true> E{BIG, DFF, RT};
        pg8::gemm_phase(lds, g, S, E, tid);
    PHASE_END

    PHASE_BEGIN
        pg8::Gemm g{BIG, W2, DFF, DFF, DFF, 0, 0}; pg8::Order S; S.init(NTOK, DM, 1, G, bid);
        pg8::EpiResidB<false> E{nullptr, HB, HB, SSQP};
        pg8::gemm_phase(lds, g, S, E, tid);
    PHASE_END

    PHASE_BEGIN
        pg8::Gemm g{HB, WA, DM, DM, DM, 0, 0}; pg8::Order S; S.init(NTOK, INC, 1, G, bid);
        fill_rstd_table(RT, SSQP, S, tid);
        pg8::EpiQkv E{BIG, TAB, RT};
        pg8::gemm_phase(lds, g, S, E, tid);
    PHASE_END

    PHASE_BEGIN
        LAS unsigned char* KS = lds + wave * (2 * 32 * HP * 2); LAS unsigned char* VS = KS + 32 * HP * 2;
        for (int it = 0; it * G < 1024; ++it) {
            const int item = (G == 256) ? ((bid & 7) * 128 + it * 32 + (bid >> 3)) : (bid + it * G);
            if (item >= 1024) break;
            const int b = item >> 9, h = (item >> 5) & 15, n = item & 31;
            const int r0 = wave, r1 = wave + 8;
            QTile t0, t1;
            const int fr_ = lane & 15;
            {
                const int pc0 = 32 * wave + fr_, pc1 = pc0 + 16;
                attn_tile_init(t0, BIG, b, h, n, 0, lane); attn_tile_init(t1, BIG, b, h, n, 0, lane);
                attn_q_load(t0, BIG, (size_t)b * SEQ + 256 * n + pc0, h, lane); attn_q_load(t1, BIG, (size_t)b * SEQ + 256 * n + pc1, h, lane);
                int g = 0;
                while (g < 12 && 256 * n - 128 + 32 * g + 31 < 0) ++g;
                const int kidx = tid >> 4, ch = tid & 15;
                u32x4 rk, rv;
                { int mk = 256 * n - 128 + 32 * g + kidx; mk = mk < 0 ? 0 : mk; const size_t row = (size_t)b * SEQ + mk;
                  rk = *(const u32x4*)(BIG + row * INC + 2048 + h * 128 + 8 * ch); rv = *(const u32x4*)(BIG + row * INC + 4096 + h * 128 + 8 * ch); }
                __syncthreads();
                int buf = 0;
#pragma unroll 1
                for (; g < 12; ++g) {
                    const int mk0 = 256 * n - 128 + 32 * g;
                    LAS unsigned char* SK = lds + buf * 17408; LAS unsigned char* SV = SK + 8704;
                    *(LAS u32x4*)(SK + (kidx * HP + 8 * ch) * 2) = rk; *(LAS u32x4*)(SV + (kidx * HP + 8 * ch) * 2) = rv;
                    __syncthreads();
                    if (g + 1 < 12) { const size_t row = (size_t)b * SEQ + (mk0 + 32 + kidx);
                        rk = *(const u32x4*)(BIG + row * INC + 2048 + h * 128 + 8 * ch); rv = *(const u32x4*)(BIG + row * INC + 4096 + h * 128 + 8 * ch); }
                    if (g >= wave && g <= wave + 4) attn_pair_update(t0, 256 * n + pc0, t1, 256 * n + pc1, mk0, lds_addr_of(SV), SK, lane);
                    buf ^= 1;
                }
                __syncthreads();
                attn_dump(t0, lds, pc0, lane); attn_dump(t1, lds, pc1, lane);
                __syncthreads();
                attn_pick(t0, lds, 16 * fr_ + r0, lane); attn_pick(t1, lds, 16 * fr_ + r1, lane);
                attn_q_load(t0, BIG, (size_t)b * SEQ + 256 * n + 16 * fr_ + r0, h, lane); attn_q_load(t1, BIG, (size_t)b * SEQ + 256 * n + 16 * fr_ + r1, h, lane);
                __syncthreads();
            }
            attn_branch<true, true>(BIG, b, h, n, 2, wave & 3, 64 * n - 128, 6, t0, r0, t1, r1, KS, VS, lane);
            attn_branch<true, false>(BIG, b, h, n, 4, r0, 16 * n - 144, 5, t0, r0, t1, r1, KS, VS, lane);
            attn_branch<false, true>(BIG, b, h, n, 4, r1, 16 * n - 144, 5, t0, r0, t1, r1, KS, VS, lane);
            attn_tile_store(t0, XN, b, h, n, r0, lane); attn_tile_store(t1, XN, b, h, n, r1, lane);
        }
        __syncthreads();
        int lane3; asm volatile("v_mbcnt_lo_u32_b32 %0, -1, 0\n\tv_mbcnt_hi_u32_b32 %0, -1, %0" : "=v"(lane3));
        transpose_job(p.w_o, DM, DM, WB, -1, nullptr, lds, gw, NGW, wave, lane3);
        transpose_job(p.w1 + (size_t)DM * DFF, DM, DFF, W1, -1, p.norm_mlp + DM, lds, gw, NGW, wave, lane3);
        transpose_job(p.w2 + (size_t)DM * DFF, DFF, DM, W2, -1, nullptr, lds, gw, NGW, wave, lane3);
    PHASE_END

    PHASE_BEGIN
        pg8::Gemm g{XN, WB, DM, DM, DM, 0, 0}; pg8::Order S; S.init(NTOK, DM, 1, G, bid);
        pg8::EpiResidB<false> E{nullptr, HB, HB, SSQP};
        pg8::gemm_phase(lds, g, S, E, tid);
    PHASE_END

    PHASE_BEGIN
        pg8::Gemm g{HB, W1, DM, DM, DM, 0, 0}; pg8::Order S; S.init(NTOK, DFF, 1, G, bid);
        fill_rstd_table(RT, SSQP, S, tid);
        pg8::EpiBf16<1, true> E{BIG, DFF, RT};
        pg8::gemm_phase(lds, g, S, E, tid);
    PHASE_END

    PHASE_BEGIN
        pg8::Gemm g{BIG, W2, DFF, DFF, DFF, 0, 0}; pg8::Order S; S.init(NTOK, DM, 1, G, bid);
        pg8::EpiResidB<false> E{nullptr, HB, HB, nullptr};
        pg8::gemm_phase(lds, g, S, E, tid);
    PHASE_END

    PHASE_BEGIN
        norm_rows_from_bf16<true>(HB, p.final_norm, nullptr, p.out, gw, NGW, lane);
    PHASE_END
#undef PHASE_BEGIN
#undef PHASE_END
}
constexpr int N_PHASES = 14;

extern "C" void kernel_launch(void* const* d_in, const int* in_sizes, int n_in, void* d_out, int out_size, void* d_ws, size_t ws_size, hipStream_t stream) {
    static int grid = 0;
    if (grid == 0) {
        if (n_in != 20 || ws_size < WS_END) { fprintf(stderr, "kernel_launch: unexpected n_in %d / ws_size %zu\n", n_in, ws_size); grid = -1; return; }
        int dev = 0, cus = 0, per_cu = 0;
        hipGetDevice(&dev);
        hipDeviceGetAttribute(&cus, hipDeviceAttributeMultiprocessorCount, dev);
        if (hipFuncSetAttribute((const void*)mega, hipFuncAttributeMaxDynamicSharedMemorySize, LDS_BYTES) != hipSuccess) { fprintf(stderr, "kernel_launch: hipFuncSetAttribute failed\n"); grid = -1; return; }
        if (hipOccupancyMaxActiveBlocksPerMultiprocessor(&per_cu, (const void*)mega, 512, LDS_BYTES) != hipSuccess || per_cu < 1) { fprintf(stderr, "kernel_launch: occupancy query says %d\n", per_cu); per_cu = 1; }
        (void)hipGetLastError();
        grid = cus * 1;
    }
    if (grid < 0) return;
    Params p{};
    p.x = (const float*)d_in[0]; p.pos = (const int*)d_in[1]; p.norm_mix = (const float*)d_in[2]; p.norm_mlp = (const float*)d_in[3]; p.final_norm = (const float*)d_in[4];
    p.w_in = (const float*)d_in[5]; p.conv_w = (const float*)d_in[6]; p.conv_b = (const float*)d_in[7]; p.w_a = (const float*)d_in[8]; p.b_a = (const float*)d_in[9];
    p.w_i = (const float*)d_in[10]; p.b_i = (const float*)d_in[11]; p.lam = (const float*)d_in[12]; p.lb_logits = (const float*)d_in[13]; p.g_norm = (const float*)d_in[14];
    p.w_out = (const float*)d_in[15]; p.w_qkv = (const float*)d_in[16]; p.w_o = (const float*)d_in[17]; p.w1 = (const float*)d_in[18]; p.w2 = (const float*)d_in[19];
    p.out = (float*)d_out; p.ws = (unsigned char*)d_ws;
    if (hipMemsetAsync((unsigned char*)d_ws + WS_CTR, 0, 256, stream) != hipSuccess) { fprintf(stderr, "kernel_launch: memset of the barrier word failed\n"); return; }
    int lo = 0, hi = N_PHASES;
    void* args[] = {&p, &lo, &hi};
    hipError_t e = hipLaunchCooperativeKernel((const void*)mega, dim3(grid), dim3(512), args, LDS_BYTES, stream);
    if (e != hipSuccess) fprintf(stderr, "kernel_launch: cooperative launch failed: %s (grid %d)\n", hipGetErrorString(e), grid);
}
```

```cpp
#include <hip/hip_runtime.h>
#include <hip/hip_cooperative_groups.h>
#include <cstdio>
namespace cg = cooperative_groups;

#define LAS __attribute__((address_space(3)))
typedef unsigned short bf16_t;
typedef short bf16x8 __attribute__((ext_vector_type(8)));
typedef short s16x4 __attribute__((ext_vector_type(4)));
typedef float f32x4 __attribute__((ext_vector_type(4)));
typedef float f32x2 __attribute__((ext_vector_type(2)));
typedef unsigned u32x4 __attribute__((ext_vector_type(4)));
typedef unsigned u32x2 __attribute__((ext_vector_type(2)));

constexpr int SEQ = 8192, NTOK = 16384, DM = 2048, DFF = 8192, INC = 6144;
constexpr int LDS_BYTES = 144 * 1024;
constexpr size_t MiB = 1024 * 1024;
constexpr size_t WS_WA = 0, WS_WB = 24 * MiB, WS_W1 = 32 * MiB, WS_W2 = 64 * MiB, WS_WG = 96 * MiB;
constexpr size_t WS_AGG = 97 * MiB, WS_DK = 98 * MiB, WS_CTR = 99 * MiB, WS_TAB = 100 * MiB;
constexpr size_t WS_XN = 104 * MiB, WS_BIG = 168 * MiB, WS_LA = WS_BIG + 192 * MiB, WS_LU = 424 * MiB, WS_END = 488 * MiB;

struct Params {
    const float* x; const int* pos; const float* norm_mix; const float* norm_mlp; const float* final_norm;
    const float* w_in; const float* conv_w; const float* conv_b; const float* w_a; const float* b_a; const float* w_i; const float* b_i;
    const float* lam; const float* lb_logits; const float* g_norm; const float* w_out; const float* w_qkv; const float* w_o; const float* w1; const float* w2;
    float* out; unsigned char* ws;
};

typedef __bf16 bf16v2_t __attribute__((ext_vector_type(2)));
__device__ __forceinline__ unsigned pk2(float lo, float hi) { bf16v2_t v; v[0] = (__bf16)lo; v[1] = (__bf16)hi; return __builtin_bit_cast(unsigned, v); }
__device__ __forceinline__ float bf2f(bf16_t b) { return __uint_as_float(((unsigned)b) << 16); }
__device__ __forceinline__ float bflo(unsigned w) { return __uint_as_float(w << 16); }
__device__ __forceinline__ float bfhi(unsigned w) { return __uint_as_float(w & 0xffff0000u); }
__device__ __forceinline__ float sigmoidf_(float x) { return __builtin_amdgcn_rcpf(1.0f + __expf(-x)); }
__device__ __forceinline__ float siluf_(float x) { return x * __builtin_amdgcn_rcpf(1.0f + __expf(-x)); }
__device__ __forceinline__ float gelu_tanh(float y) { const float z = 0.7978845608028654f * (y + 0.044715f * y * y * y); const float t = 1.0f - 2.0f / (__expf(2.0f * z) + 1.0f); return 0.5f * y * (1.0f + t); }
__device__ __forceinline__ float wave_sum(float v) {
#pragma unroll
    for (int o = 1; o < 64; o <<= 1) v += __shfl_xor(v, o);
    return v;
}
__device__ __forceinline__ void lds_wait() { asm volatile("s_waitcnt lgkmcnt(0)" ::: "memory"); }
__device__ __forceinline__ s16x4 tr_read(unsigned lds_addr) { s16x4 r; asm volatile("ds_read_b64_tr_b16 %0, %1\n\ts_waitcnt lgkmcnt(0)" : "=&v"(r) : "v"(lds_addr) : "memory"); return r; }
__device__ __forceinline__ bf16x8 cat8(s16x4 a, s16x4 b) { bf16x8 r; r[0] = a[0]; r[1] = a[1]; r[2] = a[2]; r[3] = a[3]; r[4] = b[0]; r[5] = b[1]; r[6] = b[2]; r[7] = b[3]; return r; }
__device__ __forceinline__ bf16x8 pack8(f32x4 a, f32x4 b) { u32x4 w; w.x = pk2(a[0], a[1]); w.y = pk2(a[2], a[3]); w.z = pk2(b[0], b[1]); w.w = pk2(b[2], b[3]); return __builtin_bit_cast(bf16x8, w); }
__device__ __forceinline__ unsigned lds_addr_of(LAS unsigned char* p) { return (unsigned)(size_t)p; }

namespace pg8 {
constexpr int BM = 256, BK = 64, HALF = 128, HTB = HALF * BK * 2, STAGE_BYTES = 8 * HTB, NXCD = 8, WGM = 4;
__device__ __forceinline__ int lds_byte(int r, int c) { const int st = (r >> 4) * 2 + (c >> 5), rr = r & 15, cc = c & 31, ob = rr * 64 + cc * 2; return st * 1024 + (ob ^ (((ob >> 9) & 1) << 5)); }
__device__ __forceinline__ void stage_rc(int b, int& R, int& C) { const int st = b / 1024, sb = b % 1024, swz = sb ^ (((sb >> 9) & 1) << 5); R = (st >> 1) * 16 + swz / 64; C = (st & 1) * 32 + (swz % 64) / 2; }
__device__ __forceinline__ int perm32(int rho) { const int n = rho >> 4, i = rho & 15; return 8 * (i >> 2) + 4 * n + (i & 3); }

struct Unit { int pm, pn, z, i; };
struct Gemm { const bf16_t* A; const bf16_t* Bt; int lda, ldb, K; size_t a_z, b_z; };
struct Order {
    int nM, nN, nZ, per, G, c;
    __device__ void init(int M, int N, int Z, int G_, int c_) { nM = M / BM; nN = N / BM; nZ = Z; per = nM * nN; G = G_; c = c_; }
    __device__ bool next(int i, Unit& u) const {
        const long L = (long)i * G + c; if (L >= (long)per * nZ) return false;
        const int nwg = per * nZ;
        int wgid = (int)L; { const int q = nwg / NXCD, r = nwg % NXCD, xcd = wgid % NXCD, off = wgid / NXCD; wgid = (xcd < r ? xcd * (q + 1) : r * (q + 1) + (xcd - r) * q) + off; }
        u.z = wgid / per; wgid -= u.z * per;
        const int nig = WGM * nN, gid = wgid / nig, fm = gid * WGM, gsz = (nM - fm) < WGM ? (nM - fm) : WGM;
        u.pm = fm + ((wgid % nig) % gsz); u.pn = (wgid % nig) / gsz; u.i = i; return true;
    }
};

template <class Epi>
__device__ __forceinline__ void gemm_phase(LAS unsigned char* lds, const Gemm g, const Order& S, const Epi& E, const int tid) {
    const int wid = __builtin_amdgcn_readfirstlane(tid >> 6), lane = tid & 63, wr = wid >> 2, wc = wid & 3, fr = lane & 15, fq = lane >> 4;
    const int K = g.K, nt = K / BK;
    unsigned voffA[2], voffB[2];
#pragma unroll
    for (int i = 0; i < 2; ++i) { int R, C; stage_rc(tid * 16 + i * 8192, R, C); const int Rb = Epi::PERM ? ((R & ~31) + perm32(R & 31)) : R;
        voffA[i] = (unsigned)(R * g.lda + C) * 2u; voffB[i] = (unsigned)(Rb * g.ldb + C) * 2u; }
    const size_t kstep = (size_t)(BK * 2);
    const size_t hstepA = (size_t)HALF * g.lda * 2, hstepB = (size_t)HALF * g.ldb * 2;
    const size_t tstepA = 2 * hstepA, tstepB = 2 * hstepB;
    const unsigned ldsw = (unsigned)wid * 1024u;
    const int aoff = lds_byte(wr * 64 + fr, fq * 8), boff = lds_byte(wc * 32 + fr, fq * 8);
#define PG8_SA(b, h) (((b) * 2 + (h)) * HTB)
#define PG8_SB(b, h) ((4 + (b) * 2 + (h)) * HTB)
#define PG8_STAGE(bufoff, gbase, voff) do { _Pragma("unroll") for (int _i = 0; _i < 2; ++_i) \
        __builtin_amdgcn_global_load_lds((const unsigned*)((const char*)(gbase) + (voff)[_i]), (LAS unsigned*)(lds + (bufoff) + ldsw + _i * 8192), 16, 0, 0); } while (0)
#define PG8_LDA(dst, b, h) do { _Pragma("unroll") for (int m = 0; m < 4; ++m) _Pragma("unroll") for (int k = 0; k < 2; ++k) dst[m][k] = *(const LAS bf16x8*)(lds + PG8_SA(b, h) + aoff + m * 2048 + k * 1024); } while (0)
#define PG8_LDB(dst, b, h) do { _Pragma("unroll") for (int n = 0; n < 2; ++n) _Pragma("unroll") for (int k = 0; k < 2; ++k) dst[n][k] = *(const LAS bf16x8*)(lds + PG8_SB(b, h) + boff + n * 2048 + k * 1024); } while (0)
#define PG8_MMA(ai, bj, At, Bt) do { __builtin_amdgcn_s_setprio(1); _Pragma("unroll") for (int m = 0; m < 4; ++m) _Pragma("unroll") for (int n = 0; n < 2; ++n) _Pragma("unroll") for (int k = 0; k < 2; ++k) \
        acc[ai][bj][m][n] = __builtin_amdgcn_mfma_f32_16x16x32_bf16(Bt[n][k], At[m][k], acc[ai][bj][m][n], 0, 0, 0); __builtin_amdgcn_s_setprio(0); } while (0)
#define PG8_WAIT_V(n) asm volatile("s_waitcnt vmcnt(" #n ")" ::: "memory")
#define PG8_WAIT_L(n) asm volatile("s_waitcnt lgkmcnt(" #n ")" ::: "memory")
#define PG8_BAR __builtin_amdgcn_s_barrier()
#define PG8_SCHED __builtin_amdgcn_sched_barrier(0)
    Unit cur, nxt; int ui = 0;
    if (!S.next(0, cur)) return;
    f32x4 acc[2][2][4][2];
#pragma unroll
    for (int a = 0; a < 2; ++a)
#pragma unroll
        for (int b = 0; b < 2; ++b)
#pragma unroll
            for (int m = 0; m < 4; ++m)
#pragma unroll
                for (int n = 0; n < 2; ++n) acc[a][b][m][n] = (f32x4){0.f, 0.f, 0.f, 0.f};
    bf16x8 At[4][2], B0[2][2], B1[2][2];
    const char* cA = (const char*)g.A + (size_t)cur.pm * tstepA + (size_t)cur.z * g.a_z; const char* cB = (const char*)g.Bt + (size_t)cur.pn * tstepB + (size_t)cur.z * g.b_z;
    PG8_STAGE(PG8_SB(0, 0), cB, voffB); PG8_STAGE(PG8_SA(0, 0), cA, voffA); PG8_STAGE(PG8_SB(0, 1), cB + hstepB, voffB); PG8_STAGE(PG8_SA(0, 1), cA + hstepA, voffA);
    if (wr == 1) PG8_BAR;
    PG8_WAIT_V(4); PG8_BAR;
    PG8_STAGE(PG8_SB(1, 0), cB + kstep, voffB); PG8_STAGE(PG8_SA(1, 0), cA + kstep, voffA); PG8_STAGE(PG8_SB(1, 1), cB + hstepB + kstep, voffB);
    PG8_WAIT_V(6); PG8_BAR;
    for (;;) {
        const bool has_next = S.next(ui + 1, nxt);
        const char* nA = has_next ? (const char*)g.A + (size_t)nxt.pm * tstepA + (size_t)nxt.z * g.a_z : cA; const char* nB = has_next ? (const char*)g.Bt + (size_t)nxt.pn * tstepB + (size_t)nxt.z * g.b_z : cB;
        for (int t = 0; t < nt; t += 2) {
            const bool last = (t == nt - 2);
            const char* a1 = cA + (size_t)(t + 1) * kstep;
            const char* a2 = last ? nA : cA + (size_t)(t + 2) * kstep; const char* b2 = last ? nB : cB + (size_t)(t + 2) * kstep;
            const char* a3 = a2 + kstep; const char* b3 = b2 + kstep;
            PG8_LDB(B0, 0, 0); PG8_SCHED; PG8_LDA(At, 0, 0); PG8_STAGE(PG8_SA(1, 1), a1 + hstepA, voffA);
            PG8_WAIT_L(8); PG8_BAR; PG8_WAIT_L(0); PG8_MMA(0, 0, At, B0); PG8_BAR; PG8_SCHED;
            PG8_LDB(B1, 0, 1); PG8_STAGE(PG8_SB(0, 0), b2, voffB);
            PG8_BAR; PG8_WAIT_L(0); PG8_MMA(0, 1, At, B1); PG8_BAR;
            PG8_LDA(At, 0, 1); PG8_STAGE(PG8_SA(0, 0), a2, voffA);
            PG8_BAR; PG8_WAIT_L(0); PG8_MMA(1, 0, At, B0); PG8_BAR; PG8_SCHED;
            PG8_STAGE(PG8_SB(0, 1), b2 + hstepB, voffB);
            PG8_WAIT_V(6); PG8_BAR; PG8_MMA(1, 1, At, B1); PG8_BAR;
            PG8_LDB(B0, 1, 0); PG8_SCHED; PG8_LDA(At, 1, 0); PG8_STAGE(PG8_SA(0, 1), a2 + hstepA, voffA);
            PG8_WAIT_L(8); PG8_BAR; PG8_WAIT_L(0); PG8_MMA(0, 0, At, B0); PG8_BAR; PG8_SCHED;
            PG8_LDB(B1, 1, 1); PG8_STAGE(PG8_SB(1, 0), b3, voffB);
            PG8_BAR; PG8_WAIT_L(0); PG8_MMA(0, 1, At, B1); PG8_BAR;
            PG8_LDA(At, 1, 1); PG8_STAGE(PG8_SA(1, 0), a3, voffA);
            PG8_BAR; PG8_WAIT_L(0); PG8_MMA(1, 0, At, B0); PG8_BAR; PG8_SCHED;
            PG8_STAGE(PG8_SB(1, 1), b3 + hstepB, voffB);
            PG8_WAIT_V(6); PG8_BAR; PG8_MMA(1, 1, At, B1); PG8_BAR;
        }
        E(acc, cur, wr, wc, fr, fq);
        if (!has_next) break;
#pragma unroll
        for (int a = 0; a < 2; ++a)
#pragma unroll
            for (int b = 0; b < 2; ++b)
#pragma unroll
                for (int m = 0; m < 4; ++m)
#pragma unroll
                    for (int n = 0; n < 2; ++n) acc[a][b][m][n] = (f32x4){0.f, 0.f, 0.f, 0.f};
        cur = nxt; cA = nA; cB = nB; ++ui;
    }
    PG8_WAIT_V(0);
    if (wr == 0) PG8_BAR;
    PG8_BAR;
#undef PG8_SA
#undef PG8_SB
#undef PG8_STAGE
#undef PG8_LDA
#undef PG8_LDB
#undef PG8_MMA
#undef PG8_WAIT_V
#undef PG8_WAIT_L
#undef PG8_BAR
#undef PG8_SCHED
}

template <int ACT  , bool RS = false> struct EpiBf16 {
    static constexpr bool PERM = true;
    bf16_t* O; int ldc; const LAS float* rt;
    __device__ __forceinline__ void operator()(const f32x4 (&acc)[2][2][4][2], const Unit& u, int wr, int wc, int fr, int fq) const {
        const int row0 = u.pm * BM + wr * 64 + fr, col0 = u.pn * BM + wc * 32 + 8 * fq;
#pragma unroll
        for (int ai = 0; ai < 2; ++ai)
#pragma unroll
            for (int m = 0; m < 4; ++m) { bf16_t* rowp = O + (size_t)(row0 + ai * HALF + m * 16) * ldc + col0;
                float rs = 1.0f; if (RS) rs = rt[u.i * 256 + wr * 64 + fr + ai * HALF + m * 16];
#pragma unroll
                for (int bj = 0; bj < 2; ++bj) { f32x4 v0 = acc[ai][bj][m][0], v1 = acc[ai][bj][m][1];
                    if (RS) { v0 *= rs; v1 *= rs; }
                    if (ACT == 1) {
#pragma unroll
                        for (int j = 0; j < 4; ++j) { const float a = fmaxf(v0[j], 0.f), b = fmaxf(v1[j], 0.f); v0[j] = a * a; v1[j] = b * b; } }
                    u32x4 w; w.x = pk2(v0[0], v0[1]); w.y = pk2(v0[2], v0[3]); w.z = pk2(v1[0], v1[1]); w.w = pk2(v1[2], v1[3]);
                    *(u32x4*)(rowp + bj * HALF) = w; } }
    }
};
template <bool BASE_F32> struct EpiResidB {
    static constexpr bool PERM = true;
    const float* basef; const bf16_t* baseb; bf16_t* out; float* ssqp;
    __device__ __forceinline__ void operator()(const f32x4 (&acc)[2][2][4][2], const Unit& u, int wr, int wc, int fr, int fq) const {
        const int row0 = u.pm * BM + wr * 64 + fr, col0 = u.pn * BM + wc * 32 + 8 * fq;
#pragma unroll
        for (int ai = 0; ai < 2; ++ai) {
            if (BASE_F32) {
#pragma unroll
                for (int m = 0; m < 4; m += 2) {
                    f32x4 bs[2][2][2];
#pragma unroll
                    for (int mm = 0; mm < 2; ++mm) { const size_t off = (size_t)(row0 + ai * HALF + (m + mm) * 16) * DM + col0;
#pragma unroll
                        for (int bj = 0; bj < 2; ++bj)
#pragma unroll
                            for (int n = 0; n < 2; ++n) bs[mm][bj][n] = *(const f32x4*)(basef + off + bj * HALF + n * 4); }
#pragma unroll
                    for (int mm = 0; mm < 2; ++mm) { const size_t off = (size_t)(row0 + ai * HALF + (m + mm) * 16) * DM + col0;
                        float ss = 0.f;
#pragma unroll
                        for (int bj = 0; bj < 2; ++bj) { const f32x4 v0 = bs[mm][bj][0] + acc[ai][bj][m + mm][0], v1 = bs[mm][bj][1] + acc[ai][bj][m + mm][1];
                            ss += (v0[0] * v0[0] + v0[1] * v0[1]) + (v0[2] * v0[2] + v0[3] * v0[3]) + (v1[0] * v1[0] + v1[1] * v1[1]) + (v1[2] * v1[2] + v1[3] * v1[3]);
                            u32x4 w; w.x = pk2(v0[0], v0[1]); w.y = pk2(v0[2], v0[3]); w.z = pk2(v1[0], v1[1]); w.w = pk2(v1[2], v1[3]);
                            *(u32x4*)(out + off + bj * HALF) = w; }
                        if (ssqp) { ss += __shfl_xor(ss, 16); ss += __shfl_xor(ss, 32); if (fq == 0) ssqp[(size_t)(row0 + ai * HALF + (m + mm) * 16) * 32 + u.pn * 4 + wc] = ss; } }
                    asm volatile("" ::: "memory"); }
            } else {
                u32x4 bs[4][2];
#pragma unroll
                for (int m = 0; m < 4; ++m) { const size_t off = (size_t)(row0 + ai * HALF + m * 16) * DM + col0;
#pragma unroll
                    for (int bj = 0; bj < 2; ++bj) bs[m][bj] = *(const u32x4*)(baseb + off + bj * HALF); }
#pragma unroll
                for (int m = 0; m < 4; ++m) { const size_t off = (size_t)(row0 + ai * HALF + m * 16) * DM + col0;
                    float ss = 0.f;
#pragma unroll
                    for (int bj = 0; bj < 2; ++bj) { const u32x4 q = bs[m][bj]; const f32x4 a0 = acc[ai][bj][m][0], a1 = acc[ai][bj][m][1];
                        const float h0 = bflo(q.x) + a0[0], h1 = bfhi(q.x) + a0[1], h2 = bflo(q.y) + a0[2], h3 = bfhi(q.y) + a0[3], h4 = bflo(q.z) + a1[0], h5 = bfhi(q.z) + a1[1], h6 = bflo(q.w) + a1[2], h7 = bfhi(q.w) + a1[3];
                        ss += (h0 * h0 + h1 * h1) + (h2 * h2 + h3 * h3) + (h4 * h4 + h5 * h5) + (h6 * h6 + h7 * h7);
                        u32x4 w; w.x = pk2(h0, h1); w.y = pk2(h2, h3); w.z = pk2(h4, h5); w.w = pk2(h6, h7);
                        *(u32x4*)(out + off + bj * HALF) = w; }
                    if (ssqp) { ss += __shfl_xor(ss, 16); ss += __shfl_xor(ss, 32); if (fq == 0) ssqp[(size_t)(row0 + ai * HALF + m * 16) * 32 + u.pn * 4 + wc] = ss; } }
                asm volatile("" ::: "memory");
            }
        }
    }
};
struct EpiGates {
    static constexpr bool PERM = false;
    const bf16_t* XC; const float* b_a; const float* b_i; const float* spt; unsigned* LAU;
    __device__ __forceinline__ void operator()(const f32x4 (&acc)[2][2][4][2], const Unit& u, int wr, int wc, int fr, int fq) const {
        const int row0 = u.pm * BM + wr * 64 + fr, ch0 = u.z * 256 + u.pn * 128 + wc * 32 + 4 * fq;
#pragma unroll
        for (int n = 0; n < 2; ++n) {
            const int ch = ch0 + 16 * n;
            u32x2 xw[2][4];
#pragma unroll
            for (int ai = 0; ai < 2; ++ai)
#pragma unroll
                for (int m = 0; m < 4; ++m) xw[ai][m] = *(const u32x2*)(XC + (unsigned)(row0 + ai * HALF + m * 16) * 1024u + (unsigned)ch);
            const f32x4 ba = *(const f32x4*)(b_a + ch), bi = *(const f32x4*)(b_i + ch), sp = *(const f32x4*)(spt + ch);
#pragma unroll
            for (int ai = 0; ai < 2; ++ai)
#pragma unroll
                for (int m = 0; m < 4; ++m) {
                    const unsigned off = (unsigned)(row0 + ai * HALF + m * 16) * 1024u + (unsigned)ch;
                    const float xc[4] = {bflo(xw[ai][m].x), bfhi(xw[ai][m].x), bflo(xw[ai][m].y), bfhi(xw[ai][m].y)};
                    u32x4 w;
#pragma unroll
                    for (int j = 0; j < 4; ++j) {
                        const float r = sigmoidf_(acc[ai][0][m][n][j] + ba[j]), ig = sigmoidf_(acc[ai][1][m][n][j] + bi[j]);
                        const float la = sp[j] * r, x2 = 2.0f * la;
                        const float ser = -x2 * (1.0f + x2 * (0.5f + x2 * (0.16666667f + x2 * (0.041666668f + x2 * 0.0083333338f))));
                        const float om = (x2 > -0.25f) ? ser : (1.0f - __expf(x2));
                        w[j] = pk2(la, __builtin_amdgcn_sqrtf(om) * ig * xc[j]);
                    }
                    *(u32x4*)(LAU + off) = w;
                }
        }
    }
};
struct EpiQkv {
    static constexpr bool PERM = false;
    bf16_t* O; const float* tab; const LAS float* rt;
    __device__ __forceinline__ void operator()(f32x4 (&acc)[2][2][4][2], const Unit& u, int wr, int wc, int fr, int fq) const {
        const int row0 = u.pm * BM + wr * 64 + fr, col0 = u.pn * BM + wc * 32 + 4 * fq;
        const int sec = u.pn >> 3;
        const float scale = (sec == 0) ? 0.08838834764831845f : 1.0f;
#pragma unroll
        for (int ai = 0; ai < 2; ++ai)
#pragma unroll
            for (int m = 0; m < 4; ++m) {
                const int row = row0 + ai * HALF + m * 16;
                if (sec < 2 && wc == 0) {
                    const f32x4 t0 = *(const f32x4*)(tab + (size_t)row * 32 + 8 * fq), t1 = *(const f32x4*)(tab + (size_t)row * 32 + 8 * fq + 4);
                    const float cs[4] = {t0[0], t0[2], t1[0], t1[2]}, sn[4] = {t0[1], t0[3], t1[1], t1[3]};
#pragma unroll
                    for (int bj = 0; bj < 2; ++bj)
#pragma unroll
                        for (int j = 0; j < 4; ++j) { const float a = acc[ai][bj][m][0][j], b = acc[ai][bj][m][1][j];
                            acc[ai][bj][m][0][j] = a * cs[j] - b * sn[j]; acc[ai][bj][m][1][j] = b * cs[j] + a * sn[j]; }
                }
                bf16_t* rowp = O + (size_t)row * INC + col0;
#pragma unroll
                for (int bj = 0; bj < 2; ++bj)
#pragma unroll
                    for (int n = 0; n < 2; ++n) { const f32x4 v = acc[ai][bj][m][n] * (scale * rt[u.i * 256 + wr * 64 + fr + ai * HALF + m * 16]); u32x2 w; w.x = pk2(v[0], v[1]); w.y = pk2(v[2], v[3]); *(u32x2*)(rowp + bj * HALF + n * 16) = w; }
            }
    }
};
}

__device__ __forceinline__ void transpose_item(const float* W, int K, int N, bf16_t* WT, int gate, const float* kscale, LAS float* scr, int item, int lane) {
    const int nblk = N / 64, kb = item / nblk, nb = item % nblk, k0 = 64 * kb, n0 = 64 * nb;
    const int c4 = (lane & 15) * 4, kr = lane >> 4;
    f32x4 v[16];
#pragma unroll
    for (int i = 0; i < 16; ++i) v[i] = __builtin_nontemporal_load((const f32x4*)(W + (size_t)(k0 + 4 * i + kr) * N + n0 + c4));
#pragma unroll
    for (int i = 0; i < 16; ++i) { LAS float* d = scr + (4 * i + kr) * 65 + c4; d[0] = v[i][0]; d[1] = v[i][1]; d[2] = v[i][2]; d[3] = v[i][3]; }
    lds_wait();
    const int c = lane & 7;
    f32x4 k0v = {1.f, 1.f, 1.f, 1.f}, k1v = k0v;
    if (kscale) { k0v = *(const f32x4*)(kscale + k0 + 8 * c); k1v = *(const f32x4*)(kscale + k0 + 8 * c + 4); }
#pragma unroll
    for (int j = 0; j < 8; ++j) { const int n = (lane >> 3) + 8 * j; const LAS float* s = scr + (8 * c) * 65 + n;
        u32x4 o; o.x = pk2(s[0 * 65] * k0v[0], s[1 * 65] * k0v[1]); o.y = pk2(s[2 * 65] * k0v[2], s[3 * 65] * k0v[3]); o.z = pk2(s[4 * 65] * k1v[0], s[5 * 65] * k1v[1]); o.w = pk2(s[6 * 65] * k1v[2], s[7 * 65] * k1v[3]);
        const int nn = n0 + n; const int row = gate < 0 ? nn : (256 * (nn >> 7) + 128 * gate + (nn & 127));
        *(u32x4*)(WT + (size_t)row * K + k0 + 8 * c) = o; }
    lds_wait();
}
__device__ __forceinline__ void transpose_job(const float* W, int K, int N, bf16_t* WT, int gate, const float* kscale, LAS unsigned char* lds, int gw, int NGW, int wave, int lane) {
    LAS float* scr = (LAS float*)(lds + wave * 16640);
    const int items = (K / 64) * (N / 64);
    for (int it = gw; it < items; it += NGW) transpose_item(W, K, N, WT, gate, kscale, scr, it, lane);
}
__device__ __forceinline__ void norm_rows_bf16(const float* X, const float* gain, bf16_t* O, int gw, int NGW, int lane) {
    for (int m = gw; m < NTOK; m += NGW) {
        const f32x4* xr = (const f32x4*)(X + (size_t)m * DM) + lane;
        f32x4 v[8]; float s = 0.f;
#pragma unroll
        for (int j = 0; j < 8; ++j) { v[j] = __builtin_nontemporal_load(xr + 64 * j); s += (v[j].x * v[j].x + v[j].y * v[j].y) + (v[j].z * v[j].z + v[j].w * v[j].w); }
        const float rstd = 1.0f / sqrtf(wave_sum(s) * (1.0f / DM) + 1e-6f);
        u32x2* o8 = (u32x2*)(O + (size_t)m * DM) + lane;
#pragma unroll
        for (int j = 0; j < 8; ++j) { const f32x4 g = ((const f32x4*)gain)[lane + 64 * j]; u32x2 w; w.x = pk2(v[j].x * rstd * g.x, v[j].y * rstd * g.y); w.y = pk2(v[j].z * rstd * g.z, v[j].w * rstd * g.w); o8[64 * j] = w; }
    }
}
template <bool OUT_F32>
__device__ __forceinline__ void norm_rows_from_bf16(const bf16_t* H, const float* gain, bf16_t* OB, float* OF, int gw, int NGW, int lane) {
    for (int m = gw; m < NTOK; m += NGW) {
        const u32x4* hr = (const u32x4*)(H + (size_t)m * DM) + lane;
        u32x4 q[4]; float v[4][8]; float s = 0.f;
#pragma unroll
        for (int j = 0; j < 4; ++j) q[j] = __builtin_nontemporal_load(hr + 64 * j);
#pragma unroll
        for (int j = 0; j < 4; ++j) { v[j][0] = bflo(q[j].x); v[j][1] = bfhi(q[j].x); v[j][2] = bflo(q[j].y); v[j][3] = bfhi(q[j].y); v[j][4] = bflo(q[j].z); v[j][5] = bfhi(q[j].z); v[j][6] = bflo(q[j].w); v[j][7] = bfhi(q[j].w);
#pragma unroll
            for (int e = 0; e < 8; ++e) s += v[j][e] * v[j][e]; }
        const float rstd = 1.0f / sqrtf(wave_sum(s) * (1.0f / DM) + 1e-6f);
#pragma unroll
        for (int j = 0; j < 4; ++j) {
            const int c0 = 8 * (lane + 64 * j);
            const f32x4 g0 = *(const f32x4*)(gain + c0), g1 = *(const f32x4*)(gain + c0 + 4);
            const float o0 = v[j][0] * rstd * g0[0], o1 = v[j][1] * rstd * g0[1], o2 = v[j][2] * rstd * g0[2], o3 = v[j][3] * rstd * g0[3];
            const float o4 = v[j][4] * rstd * g1[0], o5 = v[j][5] * rstd * g1[1], o6 = v[j][6] * rstd * g1[2], o7 = v[j][7] * rstd * g1[3];
            if (OUT_F32) { float* op = OF + (size_t)m * DM + c0; __builtin_nontemporal_store((f32x4){o0, o1, o2, o3}, (f32x4*)op); __builtin_nontemporal_store((f32x4){o4, o5, o6, o7}, (f32x4*)(op + 4)); }
            else { u32x4 w; w.x = pk2(o0, o1); w.y = pk2(o2, o3); w.z = pk2(o4, o5); w.w = pk2(o6, o7); *(u32x4*)(OB + (size_t)m * DM + c0) = w; }
        }
    }
}
__device__ __forceinline__ void norm_rows_f32_inplace(float* X, const float* gain, int gw, int NGW, int lane) {
    for (int m = gw; m < NTOK; m += NGW) {
        f32x4* xr = (f32x4*)(X + (size_t)m * DM) + lane;
        f32x4 v[8]; float s = 0.f;
#pragma unroll
        for (int j = 0; j < 8; ++j) { v[j] = xr[64 * j]; s += (v[j].x * v[j].x + v[j].y * v[j].y) + (v[j].z * v[j].z + v[j].w * v[j].w); }
        const float rstd = 1.0f / sqrtf(wave_sum(s) * (1.0f / DM) + 1e-6f);
#pragma unroll
        for (int j = 0; j < 8; ++j) { const f32x4 g = ((const f32x4*)gain)[lane + 64 * j]; xr[64 * j] = v[j] * rstd * g; }
    }
}

constexpr int HP = 136;
__device__ __forceinline__ bf16x8 tr_frag(unsigned base, int rowbase, int col0, int lane) {
    const int g = lane >> 4, idx = lane & 15, q = idx >> 2, p = idx & 3;
    const unsigned a0 = base + (unsigned)(((rowbase + 8 * g + q) * HP + col0 + 4 * p) * 2);
    const s16x4 lo = tr_read(a0), hi = tr_read(a0 + 4 * HP * 2);
    return cat8(lo, hi);
}

struct QTile { bf16x8 q[4]; f32x4 o[8]; float m, l; };
struct KVRegs { u32x4 k[8], v[8]; };

#define TR8(r, base, o0) asm volatile( \
    "ds_read_b64_tr_b16 %0, %8 offset:" #o0 "+0\n\tds_read_b64_tr_b16 %1, %8 offset:" #o0 "+4352\n\t" \
    "ds_read_b64_tr_b16 %2, %8 offset:" #o0 "+32\n\tds_read_b64_tr_b16 %3, %8 offset:" #o0 "+4384\n\t" \
    "ds_read_b64_tr_b16 %4, %8 offset:" #o0 "+64\n\tds_read_b64_tr_b16 %5, %8 offset:" #o0 "+4416\n\t" \
    "ds_read_b64_tr_b16 %6, %8 offset:" #o0 "+96\n\tds_read_b64_tr_b16 %7, %8 offset:" #o0 "+4448\n\t" \
    "s_waitcnt lgkmcnt(0)" \
    : "=&v"(r[0]), "=&v"(r[1]), "=&v"(r[2]), "=&v"(r[3]), "=&v"(r[4]), "=&v"(r[5]), "=&v"(r[6]), "=&v"(r[7]) : "v"(base) : "memory")

#define TR8B(r, base, o0) asm volatile( \
    "ds_read_b64_tr_b16 %0, %8 offset:" #o0 "+0\n\tds_read_b64_tr_b16 %1, %8 offset:" #o0 "+1088\n\t" \
    "ds_read_b64_tr_b16 %2, %8 offset:" #o0 "+32\n\tds_read_b64_tr_b16 %3, %8 offset:" #o0 "+1120\n\t" \
    "ds_read_b64_tr_b16 %4, %8 offset:" #o0 "+64\n\tds_read_b64_tr_b16 %5, %8 offset:" #o0 "+1152\n\t" \
    "ds_read_b64_tr_b16 %6, %8 offset:" #o0 "+96\n\tds_read_b64_tr_b16 %7, %8 offset:" #o0 "+1184\n\t" \
    "s_waitcnt lgkmcnt(0)" \
    : "=&v"(r[0]), "=&v"(r[1]), "=&v"(r[2]), "=&v"(r[3]), "=&v"(r[4]), "=&v"(r[5]), "=&v"(r[6]), "=&v"(r[7]) : "v"(base) : "memory")

__device__ __forceinline__ void attn_tile_update(QTile& t, const int mq, int mk0, unsigned VSa, LAS unsigned char* KS, int lane) {
    const int fr = lane & 15, fq = lane >> 4;
    f32x4 s0 = {0.f, 0.f, 0.f, 0.f}, s1 = {0.f, 0.f, 0.f, 0.f};
#pragma unroll
    for (int kk = 0; kk < 4; ++kk) {
        const bf16x8 a0 = *(const LAS bf16x8*)(KS + ((fr)*HP + 32 * kk + 8 * fq) * 2);
        const bf16x8 a1 = *(const LAS bf16x8*)(KS + ((16 + fr) * HP + 32 * kk + 8 * fq) * 2);
        s0 = __builtin_amdgcn_mfma_f32_16x16x32_bf16(a0, t.q[kk], s0, 0, 0, 0);
        s1 = __builtin_amdgcn_mfma_f32_16x16x32_bf16(a1, t.q[kk], s1, 0, 0, 0);
    }
    const float NEG = -__builtin_inff();
    float mx = NEG;
    bool v0[4], v1[4];
#pragma unroll
    for (int j = 0; j < 4; ++j) {
        const int mk = mk0 + 4 * fq + j, jd = mq - mk;
        v0[j] = (jd >= 0) && (jd <= 128) && (mk >= 0);
        v1[j] = (jd - 16 >= 0) && (jd - 16 <= 128) && (mk + 16 >= 0);
        if (v0[j]) mx = fmaxf(mx, s0[j]);
        if (v1[j]) mx = fmaxf(mx, s1[j]);
    }
    mx = fmaxf(mx, __shfl_xor(mx, 16)); mx = fmaxf(mx, __shfl_xor(mx, 32));
    const float mnew = fmaxf(t.m, mx);
    const float muse = (mnew == NEG) ? 0.f : mnew;
    const float alpha = __expf(t.m - muse);
    f32x4 p0, p1; float ps = 0.f;
#pragma unroll
    for (int j = 0; j < 4; ++j) { p0[j] = v0[j] ? __expf(s0[j] - muse) : 0.f; p1[j] = v1[j] ? __expf(s1[j] - muse) : 0.f; ps += p0[j] + p1[j]; }
    t.l = t.l * alpha + ps; t.m = mnew;
#pragma unroll
    for (int dt = 0; dt < 8; ++dt) t.o[dt] *= alpha;
    const bf16x8 pf = pack8(p0, p1);
    const unsigned vb = VSa + (unsigned)(((4 * fq + (fr >> 2)) * HP + 4 * (fr & 3)) * 2);
    s16x4 ra[8], rb[8];
    TR8(ra, vb, 0);
    TR8(rb, vb, 128);
#pragma unroll
    for (int dt = 0; dt < 4; ++dt) t.o[dt] = __builtin_amdgcn_mfma_f32_16x16x32_bf16(cat8(ra[2 * dt], ra[2 * dt + 1]), pf, t.o[dt], 0, 0, 0);
#pragma unroll
    for (int dt = 0; dt < 4; ++dt) t.o[4 + dt] = __builtin_amdgcn_mfma_f32_16x16x32_bf16(cat8(rb[2 * dt], rb[2 * dt + 1]), pf, t.o[4 + dt], 0, 0, 0);
}

__device__ __forceinline__ void attn_pair_update(QTile& t0, const int mq0, QTile& t1, const int mq1, int mk0, unsigned VSa, LAS unsigned char* KS, int lane) {
    const int fr = lane & 15, fq = lane >> 4;
    f32x4 s00 = {0.f, 0.f, 0.f, 0.f}, s01 = s00, s10 = s00, s11 = s00;
#pragma unroll
    for (int kk = 0; kk < 4; ++kk) {
        const bf16x8 a0 = *(const LAS bf16x8*)(KS + ((fr)*HP + 32 * kk + 8 * fq) * 2);
        const bf16x8 a1 = *(const LAS bf16x8*)(KS + ((16 + fr) * HP + 32 * kk + 8 * fq) * 2);
        s00 = __builtin_amdgcn_mfma_f32_16x16x32_bf16(a0, t0.q[kk], s00, 0, 0, 0);
        s01 = __builtin_amdgcn_mfma_f32_16x16x32_bf16(a1, t0.q[kk], s01, 0, 0, 0);
        s10 = __builtin_amdgcn_mfma_f32_16x16x32_bf16(a0, t1.q[kk], s10, 0, 0, 0);
        s11 = __builtin_amdgcn_mfma_f32_16x16x32_bf16(a1, t1.q[kk], s11, 0, 0, 0);
    }
    const float NEG = -__builtin_inff();
    float mx0 = NEG, mx1 = NEG;
#pragma unroll
    for (int j = 0; j < 4; ++j) {
        const int mk = mk0 + 4 * fq + j, jd0 = mq0 - mk, jd1 = mq1 - mk;
        const bool kv0 = (mk >= 0), kv1 = (mk + 16 >= 0);
        if (!((jd0 >= 0) && (jd0 <= 128) && kv0)) s00[j] = NEG;
        if (!((jd0 - 16 >= 0) && (jd0 - 16 <= 128) && kv1)) s01[j] = NEG;
        if (!((jd1 >= 0) && (jd1 <= 128) && kv0)) s10[j] = NEG;
        if (!((jd1 - 16 >= 0) && (jd1 - 16 <= 128) && kv1)) s11[j] = NEG;
        mx0 = fmaxf(mx0, fmaxf(s00[j], s01[j])); mx1 = fmaxf(mx1, fmaxf(s10[j], s11[j]));
    }
    { const float a = __shfl_xor(mx0, 16), b = __shfl_xor(mx1, 16); mx0 = fmaxf(mx0, a); mx1 = fmaxf(mx1, b); }
    { const float a = __shfl_xor(mx0, 32), b = __shfl_xor(mx1, 32); mx0 = fmaxf(mx0, a); mx1 = fmaxf(mx1, b); }
    const float mn0 = fmaxf(t0.m, mx0), mn1 = fmaxf(t1.m, mx1);
    const float mu0 = (mn0 == NEG) ? 0.f : mn0, mu1 = (mn1 == NEG) ? 0.f : mn1;
    const float al0 = __expf(t0.m - mu0), al1 = __expf(t1.m - mu1);
    f32x4 p00, p01, p10, p11; float ps0 = 0.f, ps1 = 0.f;
#pragma unroll
    for (int j = 0; j < 4; ++j) {
        p00[j] = __expf(s00[j] - mu0); p01[j] = __expf(s01[j] - mu0); p10[j] = __expf(s10[j] - mu1); p11[j] = __expf(s11[j] - mu1);
        ps0 += p00[j] + p01[j]; ps1 += p10[j] + p11[j];
    }
    t0.l = t0.l * al0 + ps0; t0.m = mn0; t1.l = t1.l * al1 + ps1; t1.m = mn1;
#pragma unroll
    for (int dt = 0; dt < 8; ++dt) { t0.o[dt] *= al0; t1.o[dt] *= al1; }
    const bf16x8 pf0 = pack8(p00, p01), pf1 = pack8(p10, p11);
    const unsigned vb = VSa + (unsigned)(((4 * fq + (fr >> 2)) * HP + 4 * (fr & 3)) * 2);
    s16x4 ra[8];
    TR8(ra, vb, 0);
#pragma unroll
    for (int dt = 0; dt < 4; ++dt) { const bf16x8 vf = cat8(ra[2 * dt], ra[2 * dt + 1]);
        t0.o[dt] = __builtin_amdgcn_mfma_f32_16x16x32_bf16(vf, pf0, t0.o[dt], 0, 0, 0); t1.o[dt] = __builtin_amdgcn_mfma_f32_16x16x32_bf16(vf, pf1, t1.o[dt], 0, 0, 0); }
    s16x4 rb[8];
    TR8(rb, vb, 128);
#pragma unroll
    for (int dt = 0; dt < 4; ++dt) { const bf16x8 vf = cat8(rb[2 * dt], rb[2 * dt + 1]);
        t0.o[4 + dt] = __builtin_amdgcn_mfma_f32_16x16x32_bf16(vf, pf0, t0.o[4 + dt], 0, 0, 0); t1.o[4 + dt] = __builtin_amdgcn_mfma_f32_16x16x32_bf16(vf, pf1, t1.o[4 + dt], 0, 0, 0); }
}

__device__ __forceinline__ void attn_load(KVRegs& R, const bf16_t* QKV, int b, int h, int dsh, int rd, int mk0, int lane) {
#pragma unroll
    for (int it = 0; it < 8; ++it) {
        const int kidx = 4 * it + (lane >> 4), ch = lane & 15;
        int mk = mk0 + kidx; mk = mk < 0 ? 0 : mk;
        const size_t row = (size_t)b * SEQ + ((size_t)mk << dsh) + rd;
        R.k[it] = *(const u32x4*)(QKV + row * INC + 2048 + h * 128 + 8 * ch);
        R.v[it] = *(const u32x4*)(QKV + row * INC + 4096 + h * 128 + 8 * ch);
    }
}
__device__ __forceinline__ void attn_stage(const KVRegs& R, LAS unsigned char* KS, LAS unsigned char* VS, int lane) {
#pragma unroll
    for (int it = 0; it < 8; ++it) {
        const int kidx = 4 * it + (lane >> 4), ch = lane & 15;
        *(LAS u32x4*)(KS + (kidx * HP + 8 * ch) * 2) = R.k[it];
        *(LAS u32x4*)(VS + (kidx * HP + 8 * ch) * 2) = R.v[it];
    }
    lds_wait();
}
template <bool T0, bool T1>
__device__ __forceinline__ void attn_branch(const bf16_t* QKV, int b, int h, int n, int dsh, int rd, int mkbase, int ng, QTile& t0, int r0, QTile& t1, int r1, LAS unsigned char* KS, LAS unsigned char* VS, int lane) {
    int g = 0;
    while (g < ng && mkbase + 32 * g + 31 < 0) ++g;
    if (g >= ng) return;
    KVRegs R;
    attn_load(R, QKV, b, h, dsh, rd, mkbase + 32 * g, lane);
    const unsigned VSa = lds_addr_of(VS);
#pragma unroll 1
    for (; g < ng; ++g) {
        const int mk0 = mkbase + 32 * g;
        attn_stage(R, KS, VS, lane);
        if (g + 1 < ng) attn_load(R, QKV, b, h, dsh, rd, mk0 + 32, lane);
        const int mqa = (256 * n + 16 * (lane & 15) + r0 - rd) >> dsh, mqb = (256 * n + 16 * (lane & 15) + r1 - rd) >> dsh;
        if (T0 && T1) attn_pair_update(t0, mqa, t1, mqb, mk0, VSa, KS, lane);
        else if (T0) attn_tile_update(t0, mqa, mk0, VSa, KS, lane);
        else attn_tile_update(t1, mqb, mk0, VSa, KS, lane);
        lds_wait();
    }
}

__device__ __forceinline__ void attn_tile_init(QTile& t, const bf16_t* QKV, int b, int h, int n, int r, int lane) {
    const int fr = lane & 15, fq = lane >> 4;
    const size_t row = (size_t)b * SEQ + 256 * n + 16 * fr + r;
#pragma unroll
    for (int kk = 0; kk < 4; ++kk) t.q[kk] = *(const bf16x8*)(QKV + row * INC + h * 128 + 32 * kk + 8 * fq);
#pragma unroll
    for (int dt = 0; dt < 8; ++dt) t.o[dt] = (f32x4){0.f, 0.f, 0.f, 0.f};
    t.m = -__builtin_inff(); t.l = 0.f;
}
__device__ __forceinline__ unsigned ex_off(int p, int dt, int fq) { return (unsigned)(p * 528 + ((dt ^ ((p >> 4) & 7)) * 64) + fq * 16); }
__device__ __forceinline__ void attn_q_load(QTile& t, const bf16_t* QKV, size_t row, int h, int lane) {
    const int fq = lane >> 4;
#pragma unroll
    for (int kk = 0; kk < 4; ++kk) t.q[kk] = *(const bf16x8*)(QKV + row * INC + h * 128 + 32 * kk + 8 * fq);
}
__device__ __forceinline__ void attn_dump(QTile& t, LAS unsigned char* lds, int p, int lane) {
    asm volatile("" : "+v"(p));
    const int fq = lane >> 4;
    float l = t.l; l += __shfl_xor(l, 16); l += __shfl_xor(l, 32);
#pragma unroll
    for (int dt = 0; dt < 8; ++dt) *(LAS f32x4*)(lds + ex_off(p, dt, fq)) = t.o[dt];
    if (fq == 0) *(LAS f32x2*)(lds + 135168 + p * 8) = (f32x2){t.m, l};
}
__device__ __forceinline__ void attn_pick(QTile& t, LAS unsigned char* lds, int p, int lane) {
    asm volatile("" : "+v"(p));
    const int fq = lane >> 4;
#pragma unroll
    for (int dt = 0; dt < 8; ++dt) t.o[dt] = *(const LAS f32x4*)(lds + ex_off(p, dt, fq));
    const f32x2 ml = *(const LAS f32x2*)(lds + 135168 + p * 8);
    t.m = ml.x; t.l = ml.y * 0.25f;
}
__device__ __forceinline__ void attn_tile_store(QTile& t, bf16_t* ATT, int b, int h, int n, int r, int lane) {
    const int fr = lane & 15, fq = lane >> 4;
    float l = t.l; l += __shfl_xor(l, 16); l += __shfl_xor(l, 32);
    const float inv = 1.0f / l;
    const size_t row = (size_t)b * SEQ + 256 * n + 16 * fr + r;
#pragma unroll
    for (int dt = 0; dt < 8; ++dt) { const f32x4 v = t.o[dt] * inv; u32x2 w; w.x = pk2(v[0], v[1]); w.y = pk2(v[2], v[3]); *(u32x2*)(ATT + row * DM + h * 128 + 16 * dt + 4 * fq) = w; }
}

__device__ __forceinline__ void fill_rstd_table(LAS float* RT, const float* SSQP, const pg8::Order& S, int tid) {
    pg8::Unit uu;
    for (int i = 0; S.next(i, uu); ++i) {
        if (tid < 256) {
            const f32x4* pp = (const f32x4*)(SSQP + (size_t)(uu.pm * 256 + tid) * 32);
            float sacc = 0.f;
#pragma unroll
            for (int q = 0; q < 8; ++q) { const f32x4 v = pp[q]; sacc += (v[0] + v[1]) + (v[2] + v[3]); }
            RT[i * 256 + tid] = 1.0f / sqrtf(sacc * (1.0f / DM) + 1e-6f);
        }
    }
    __syncthreads();
}

__device__ __forceinline__ void grid_barrier(unsigned* ctr, unsigned target, int wave) {
    int lane; asm volatile("v_mbcnt_lo_u32_b32 %0, -1, 0\n\tv_mbcnt_hi_u32_b32 %0, -1, %0" : "=v"(lane));
    asm volatile("s_waitcnt vmcnt(0) lgkmcnt(0)" ::: "memory");
    __syncthreads();
    if (wave == 0) {
        __builtin_amdgcn_fence(__ATOMIC_RELEASE, "agent");
        if (lane == 0) {
            __hip_atomic_fetch_add(ctr, 1u, __ATOMIC_RELAXED, __HIP_MEMORY_SCOPE_AGENT);
            while (__hip_atomic_load(ctr, __ATOMIC_RELAXED, __HIP_MEMORY_SCOPE_AGENT) < target) __builtin_amdgcn_s_sleep(8);
        }
        __builtin_amdgcn_fence(__ATOMIC_ACQUIRE, "agent");
        asm volatile("s_waitcnt vmcnt(0)" ::: "memory");
    }
    __syncthreads();
}

__global__ void __launch_bounds__(512, 2) mega(Params p, int ph_lo, int ph_hi) {
    extern __shared__ __attribute__((aligned(16))) unsigned char lds_raw[];
    LAS unsigned char* lds = (LAS unsigned char*)lds_raw;
    cg::grid_group grid = cg::this_grid();
    const int wave = __builtin_amdgcn_readfirstlane(threadIdx.x >> 6);
    const int G = gridDim.x, bid = blockIdx.x;
    const int gw = bid * 8 + wave, NGW = G * 8;
    const int NGT = G * 512;
    unsigned char* ws = p.ws;
    bf16_t* WA = (bf16_t*)(ws + WS_WA); bf16_t* WB = (bf16_t*)(ws + WS_WB); bf16_t* W1 = (bf16_t*)(ws + WS_W1); bf16_t* W2 = (bf16_t*)(ws + WS_W2); bf16_t* WG = (bf16_t*)(ws + WS_WG);
    f32x2* AGG = (f32x2*)(ws + WS_AGG); float* DK = (float*)(ws + WS_DK); float* TAB = (float*)(ws + WS_TAB);
    bf16_t* XN = (bf16_t*)(ws + WS_XN); bf16_t* BIG = (bf16_t*)(ws + WS_BIG); float* SSQP = (float*)(ws + WS_TAB + 2 * MiB); LAS float* RT = (LAS float*)(lds + pg8::STAGE_BYTES);
    unsigned* LAU = (unsigned*)(ws + WS_LA); bf16_t* HB = (bf16_t*)(ws + WS_LU);
    bf16_t* SSTB = (bf16_t*)p.out;
    grid.sync();
    int ph = 0, nbar = 0;
    unsigned* CTR = (unsigned*)(ws + WS_CTR); float* SPT = (float*)(ws + WS_CTR + 4096);
#ifndef DUPMASK
#define DUPMASK 0
#endif
#define PHASE_BEGIN if (ph >= ph_lo && ph < ph_hi) { for (int rep = 0; rep <= ((DUPMASK >> ph) & 1); ++rep) { if (ph > ph_lo || rep > 0) { \
        ++nbar; grid_barrier(CTR, (unsigned)nbar * (unsigned)G, wave); } \
    int lane; asm volatile("v_mbcnt_lo_u32_b32 %0, -1, 0\n\tv_mbcnt_hi_u32_b32 %0, -1, %0" : "=v"(lane)); const int tid = wave * 64 + lane; const int gt = bid * 512 + tid; (void)gt;
#define PHASE_END } } ++ph;

    PHASE_BEGIN
        transpose_job(p.w_in, DM, INC, WA, -1, nullptr, lds, gw, NGW, wave, lane);
#pragma unroll 1
        for (int hh = 0; hh < 4; ++hh) {
            transpose_job(p.w_a + (size_t)hh * 65536, 256, 256, WG + (size_t)hh * 131072, 0, nullptr, lds, gw, NGW, wave, lane);
            transpose_job(p.w_i + (size_t)hh * 65536, 256, 256, WG + (size_t)hh * 131072, 1, nullptr, lds, gw, NGW, wave, lane);
        }
        transpose_job(p.w_out, DM, DM, WB, -1, nullptr, lds, gw, NGW, wave, lane);
        transpose_job(p.w1, DM, DFF, W1, -1, p.norm_mlp, lds, gw, NGW, wave, lane);
        transpose_job(p.w2, DFF, DM, W2, -1, nullptr, lds, gw, NGW, wave, lane);
        norm_rows_bf16(p.x, p.norm_mix, XN, gw, NGW, lane);
        if (gt < 1024) SPT[gt] = -8.0f * log1pf(__expf(-p.lam[gt]));
    PHASE_END

    PHASE_BEGIN
        pg8::Gemm g{XN, WA, DM, DM, DM, 0, 0}; pg8::Order S; S.init(NTOK, INC, 1, G, bid);
        pg8::EpiBf16<0> E{BIG, INC, nullptr};
        pg8::gemm_phase(lds, g, S, E, tid);
    PHASE_END

    PHASE_BEGIN
        for (int idx = gt; idx < NTOK * 128; idx += NGT) {
            const int t = idx >> 7, c8 = (idx & 127) * 8, pos = t & (SEQ - 1);
            float a[8];
            { const f32x4 b0 = *(const f32x4*)(p.conv_b + c8), b1 = *(const f32x4*)(p.conv_b + c8 + 4); a[0] = b0[0]; a[1] = b0[1]; a[2] = b0[2]; a[3] = b0[3]; a[4] = b1[0]; a[5] = b1[1]; a[6] = b1[2]; a[7] = b1[3]; }
#pragma unroll
            for (int j = 0; j < 4; ++j) {
                if (pos - 3 + j >= 0) {
                    const u32x4 xw = *(const u32x4*)(BIG + (size_t)(t - 3 + j) * INC + c8);
                    const f32x4 w0 = *(const f32x4*)(p.conv_w + j * 1024 + c8), w1 = *(const f32x4*)(p.conv_w + j * 1024 + c8 + 4);
                    a[0] += w0[0] * bflo(xw.x); a[1] += w0[1] * bfhi(xw.x); a[2] += w0[2] * bflo(xw.y); a[3] += w0[3] * bfhi(xw.y);
                    a[4] += w1[0] * bflo(xw.z); a[5] += w1[1] * bfhi(xw.z); a[6] += w1[2] * bflo(xw.w); a[7] += w1[3] * bfhi(xw.w);
                }
            }
            u32x4 o; o.x = pk2(a[0], a[1]); o.y = pk2(a[2], a[3]); o.z = pk2(a[4], a[5]); o.w = pk2(a[6], a[7]);
            *(u32x4*)(XN + (size_t)t * 1024 + c8) = o;
        }
        {
            LAS unsigned char* KT = lds; LAS unsigned char* VS = lds + 64 * HP * 2; LAS float* EX = (LAS float*)(lds + 2 * 64 * HP * 2);
            const int k = tid & 127, I = tid >> 7;
            const int fr = lane & 15, fq = lane >> 4;
            for (int unit = bid; unit < 2048; unit += G) {
                const int c = unit & 127, bh = unit >> 7, h = bh & 7, b = bh >> 3;
                const size_t row0 = (size_t)b * SEQ + c * 64;
                const int chn = h * 128 + k;
                const float l0 = p.lb_logits[chn], l1 = p.lb_logits[1024 + chn], l2 = p.lb_logits[2048 + chn];
                bf16_t fzr[16];
#pragma unroll
                for (int i = 0; i < 16; ++i) fzr[i] = BIG[(row0 + 16 * I + i) * INC + 3072 + chn];
                u32x4 vst[2];
#pragma unroll
                for (int i = 0; i < 2; ++i) { const int idx = tid + 512 * i, r = idx >> 4, ch = idx & 15; vst[i] = *(const u32x4*)(BIG + (row0 + r) * INC + 4096 + h * 128 + 8 * ch); }
                __builtin_amdgcn_sched_barrier(0);
                float lb; { const float mxl = fmaxf(l0, fmaxf(l1, l2)); const float e0 = __expf(l0 - mxl), e1 = __expf(l1 - mxl), e2 = __expf(l2 - mxl); lb = e0 / (e0 + e1 + e2); }
                float lf[16], kk[16]; float tot = 0.f;
#pragma unroll
                for (int i = 0; i < 16; ++i) { const float fz = bf2f(fzr[i]); const float sg = sigmoidf_(fz); lf[i] = __logf(lb + (1.0f - lb) * sg); kk[i] = (1.0f - lb) * __builtin_amdgcn_rcpf(1.0f + __expf(fz)); tot += lf[i]; }
                __syncthreads();
                EX[I * 128 + k] = tot;
#pragma unroll
                for (int i = 0; i < 2; ++i) { const int idx = tid + 512 * i, r = idx >> 4, ch = idx & 15; *(LAS u32x4*)(VS + (r * HP + 8 * ch) * 2) = vst[i]; }
                __syncthreads();
                float prefix = 0.f, total = 0.f;
#pragma unroll
                for (int ii = 0; ii < 4; ++ii) { const float e = EX[ii * 128 + k]; total += e; if (ii < I) prefix += e; }
                if (I == 0) DK[(size_t)unit * 128 + k] = __expf(total);
                float bc = prefix;
#pragma unroll
                for (int i = 0; i < 16; ++i) { bc += lf[i]; const float kt = kk[i] * __expf(total - bc); *(LAS bf16_t*)(KT + ((16 * I + i) * HP + k) * 2) = (bf16_t)(pk2(kt, 0.f) & 0xffffu); }
                __syncthreads();
                const unsigned KTa = lds_addr_of(KT), VSa = lds_addr_of(VS);
                f32x4 acc[8];
#pragma unroll
                for (int vt = 0; vt < 8; ++vt) acc[vt] = (f32x4){0.f, 0.f, 0.f, 0.f};
#pragma unroll
                for (int k2 = 0; k2 < 2; ++k2) {
                    const bf16x8 a = tr_frag(KTa, 32 * k2, 16 * wave, lane);
                    const unsigned vb = VSa + (unsigned)(((32 * k2 + 8 * fq + (fr >> 2)) * HP + 4 * (fr & 3)) * 2);
                    s16x4 ra[8], rb[8];
                    TR8B(ra, vb, 0); TR8B(rb, vb, 128);
#pragma unroll
                    for (int vt = 0; vt < 4; ++vt) acc[vt] = __builtin_amdgcn_mfma_f32_16x16x32_bf16(a, cat8(ra[2 * vt], ra[2 * vt + 1]), acc[vt], 0, 0, 0);
#pragma unroll
                    for (int vt = 0; vt < 4; ++vt) acc[4 + vt] = __builtin_amdgcn_mfma_f32_16x16x32_bf16(a, cat8(rb[2 * vt], rb[2 * vt + 1]), acc[4 + vt], 0, 0, 0);
                }
#pragma unroll
                for (int vt = 0; vt < 8; ++vt) { u32x2 w; w.x = pk2(acc[vt][0], acc[vt][1]); w.y = pk2(acc[vt][2], acc[vt][3]);
                    *(u32x2*)(SSTB + ((size_t)unit * 128 + 16 * vt + fr) * 128 + 16 * wave + 4 * fq) = w; }
            }
            __syncthreads();
        }
    PHASE_END

    PHASE_BEGIN
        {
            pg8::Gemm g{XN, WG, 1024, 256, 256, (size_t)256 * 2, (size_t)512 * 256 * 2}; pg8::Order S; S.init(NTOK, 512, 4, G, bid);
            pg8::EpiGates E{XN, p.b_a, p.b_i, SPT, LAU};
            pg8::gemm_phase(lds, g, S, E, tid);
        }
        int lane2; asm volatile("v_mbcnt_lo_u32_b32 %0, -1, 0\n\tv_mbcnt_hi_u32_b32 %0, -1, %0" : "=v"(lane2));
        {
            pg8::Order S; S.init(NTOK, 512, 4, G, bid); pg8::Unit uu;
            const int tid2 = wave * 64 + lane2, half = tid2 >> 8, sub = (tid2 >> 7) & 1, chl = tid2 & 127;
            for (int i = 0; S.next(i, uu); ++i) {
                const int ch = uu.z * 256 + uu.pn * 128 + chl, cidx = 2 * uu.pm + half;
                const unsigned* src = LAU + ((size_t)cidx * 128 + 64 * sub) * 1024 + ch;
                float P = 1.f, H = 0.f;
#pragma unroll 16
                for (int t = 0; t < 64; ++t) { const unsigned w = src[(size_t)t * 1024]; const float a = __expf(bflo(w)); H = a * H + bfhi(w); P *= a; }
                LAS float* X2 = (LAS float*)lds;
                if (sub == 1) { X2[(half * 128 + chl) * 2] = P; X2[(half * 128 + chl) * 2 + 1] = H; }
                __syncthreads();
                if (sub == 0) { const float P1 = X2[(half * 128 + chl) * 2], H1 = X2[(half * 128 + chl) * 2 + 1]; AGG[(size_t)cidx * 1024 + ch] = (f32x2){P * P1, P1 * H + H1}; }
                __syncthreads();
            }
        }
        if (rep == 0) for (int gid = bid * 512 + wave * 64 + lane2; gid < 131072; gid += NGT) {
            const int bh = gid >> 13, e = gid & 8191, v = e >> 6, k2 = (e & 63) * 2;
            f32x2 s = {0.f, 0.f};
            unsigned* base = (unsigned*)(SSTB + ((size_t)bh * 128 * 128 + v) * 128 + k2);
            const float* dbase = DK + (size_t)bh * 128 * 128 + k2;
#pragma unroll 1
            for (int c0 = 0; c0 < 128; c0 += 8) {
                unsigned tw[8]; f32x2 dd[8];
#pragma unroll
                for (int u = 0; u < 8; ++u) { tw[u] = base[(size_t)(c0 + u) * 8192]; dd[u] = *(const f32x2*)(dbase + (size_t)(c0 + u) * 128); }
#pragma unroll
                for (int u = 0; u < 8; ++u) { base[(size_t)(c0 + u) * 8192] = pk2(s.x, s.y); s = dd[u] * s + (f32x2){bflo(tw[u]), bfhi(tw[u])}; }
            }
        }
    PHASE_END

    PHASE_BEGIN
        __syncthreads();
        {
            LAS unsigned char* QT = lds; LAS unsigned char* AI = lds + 17408; LAS unsigned char* VS = lds + 2 * 17408; LAS unsigned char* BI = lds + 3 * 17408;
            LAS unsigned char* SC = BI + 160 * HP * 2; LAS float* EX = (LAS float*)(SC + 8 * 2304); LAS float* SSQ = EX + 1024;
            const int k = tid & 127, I = tid >> 7;
            const int fr = lane & 15, fq = lane >> 4;
            const int wI = wave & 3, vh = wave >> 2;
            for (int unit = bid; unit < 2048; unit += G) {
                const int c = unit & 127, bh = unit >> 7, h = bh & 7, b = bh >> 3;
                const size_t row0 = (size_t)b * SEQ + c * 64;
                const int chn = h * 128 + k;
                const float l0 = p.lb_logits[chn], l1 = p.lb_logits[1024 + chn], l2 = p.lb_logits[2048 + chn];
                bf16_t fzr[16], qr[16];
#pragma unroll
                for (int i = 0; i < 16; ++i) { fzr[i] = BIG[(row0 + 16 * I + i) * INC + 3072 + chn]; qr[i] = BIG[(row0 + 16 * I + i) * INC + 2048 + chn]; }
                u32x4 vst[2];
#pragma unroll
                for (int i = 0; i < 2; ++i) { const int idx = tid + 512 * i, r = idx >> 4, ch = idx & 15; vst[i] = *(const u32x4*)(BIG + (row0 + r) * INC + 4096 + h * 128 + 8 * ch); }
                bf16x8 sin[4][4];
#pragma unroll
                for (int kq = 0; kq < 4; ++kq)
#pragma unroll
                    for (int vt = 0; vt < 4; ++vt) sin[kq][vt] = *(const bf16x8*)(SSTB + ((size_t)unit * 128 + 64 * vh + 16 * vt + fr) * 128 + 32 * kq + 8 * fq);
                const size_t orow = row0 + 16 * wI + fr;
                u32x2 graw[4]; f32x4 gnv[4];
#pragma unroll
                for (int vt = 0; vt < 4; ++vt) { const int v = 64 * vh + 16 * vt + 4 * fq; graw[vt] = *(const u32x2*)(BIG + orow * INC + 5120 + h * 128 + v); gnv[vt] = *(const f32x4*)(p.g_norm + h * 128 + v); }
                __builtin_amdgcn_sched_barrier(0);
                float lb; { const float mxl = fmaxf(l0, fmaxf(l1, l2)); const float e0 = __expf(l0 - mxl), e1 = __expf(l1 - mxl), e2 = __expf(l2 - mxl); lb = e0 / (e0 + e1 + e2); }
                float lf[16], kk[16]; float tot = 0.f;
#pragma unroll
                for (int i = 0; i < 16; ++i) { const float fz = bf2f(fzr[i]); const float sg = sigmoidf_(fz); lf[i] = __logf(lb + (1.0f - lb) * sg); kk[i] = (1.0f - lb) * __builtin_amdgcn_rcpf(1.0f + __expf(fz)); tot += lf[i]; }
                __syncthreads();
                EX[I * 128 + k] = tot; EX[512 + I * 128 + k] = lf[0];
#pragma unroll
                for (int i = 0; i < 2; ++i) { const int idx = tid + 512 * i, r = idx >> 4, ch = idx & 15; *(LAS u32x4*)(VS + (r * HP + 8 * ch) * 2) = vst[i]; }
                __syncthreads();
                float bref[4]; float prefix = 0.f;
                { float run = 0.f;
#pragma unroll
                  for (int ii = 0; ii < 4; ++ii) { bref[ii] = run + EX[512 + ii * 128 + k]; if (ii == I) prefix = run; run += EX[ii * 128 + k]; } }
                float brefI = bref[0];
#pragma unroll
                for (int ii = 1; ii < 4; ++ii) if (ii == I) brefI = bref[ii];
                float bc = prefix;
#pragma unroll
                for (int i = 0; i < 16; ++i) {
                    bc += lf[i];
                    const int t = 16 * I + i;
                    const float qs = siluf_(bf2f(qr[i]));
                    *(LAS bf16_t*)(QT + (t * HP + k) * 2) = (bf16_t)(pk2(qs * __expf(bc), 0.f) & 0xffffu);
                    *(LAS bf16_t*)(AI + (t * HP + k) * 2) = (bf16_t)(pk2(qs * __expf(bc - brefI), 0.f) & 0xffffu);
#pragma unroll
                    for (int ii = 0; ii < 4; ++ii) if (ii >= I) { const int offB = 8 * ii * (ii + 1); *(LAS bf16_t*)(BI + ((offB + t) * HP + k) * 2) = (bf16_t)(pk2(kk[i] * __expf(bref[ii] - bc), 0.f) & 0xffffu); }
                }
                __syncthreads();
                LAS unsigned char* SCw = SC + wave * 2304;
                const int offBI = 8 * wI * (wI + 1);
#pragma unroll
                for (int J = 0; J < 4; ++J) {
                    u32x2 w = {0u, 0u};
                    if (J <= wI) {
                        f32x4 sacc = {0.f, 0.f, 0.f, 0.f};
#pragma unroll
                        for (int kq = 0; kq < 4; ++kq) {
                            const bf16x8 a = *(const LAS bf16x8*)(BI + ((offBI + 16 * J + fr) * HP + 32 * kq + 8 * fq) * 2);
                            const bf16x8 bq = *(const LAS bf16x8*)(AI + ((16 * wI + fr) * HP + 32 * kq + 8 * fq) * 2);
                            sacc = __builtin_amdgcn_mfma_f32_16x16x32_bf16(a, bq, sacc, 0, 0, 0);
                        }
#pragma unroll
                        for (int j = 0; j < 4; ++j) if (16 * J + 4 * fq + j > 16 * wI + fr) sacc[j] = 0.f;
                        w.x = pk2(sacc[0], sacc[1]); w.y = pk2(sacc[2], sacc[3]);
                    }
                    *(LAS u32x2*)(SCw + (fr * 72 + 16 * J + 4 * fq) * 2) = w;
                }
                lds_wait();
                f32x4 o[4];
#pragma unroll
                for (int vt = 0; vt < 4; ++vt) o[vt] = (f32x4){0.f, 0.f, 0.f, 0.f};
#pragma unroll
                for (int kq = 0; kq < 4; ++kq) {
                    const bf16x8 bq = *(const LAS bf16x8*)(QT + ((16 * wI + fr) * HP + 32 * kq + 8 * fq) * 2);
#pragma unroll
                    for (int vt = 0; vt < 4; ++vt) o[vt] = __builtin_amdgcn_mfma_f32_16x16x32_bf16(sin[kq][vt], bq, o[vt], 0, 0, 0);
                }
                const unsigned VSa = lds_addr_of(VS);
#pragma unroll
                for (int k2 = 0; k2 < 2; ++k2) {
                    const bf16x8 bs = *(const LAS bf16x8*)(SCw + (fr * 72 + 32 * k2 + 8 * fq) * 2);
                    const unsigned vb = VSa + (unsigned)(((32 * k2 + 8 * fq + (fr >> 2)) * HP + 64 * vh + 4 * (fr & 3)) * 2);
                    s16x4 ra[8];
                    TR8B(ra, vb, 0);
#pragma unroll
                    for (int vt = 0; vt < 4; ++vt) o[vt] = __builtin_amdgcn_mfma_f32_16x16x32_bf16(cat8(ra[2 * vt], ra[2 * vt + 1]), bs, o[vt], 0, 0, 0);
                }
                float ssq = 0.f;
#pragma unroll
                for (int vt = 0; vt < 4; ++vt) ssq += (o[vt][0] * o[vt][0] + o[vt][1] * o[vt][1]) + (o[vt][2] * o[vt][2] + o[vt][3] * o[vt][3]);
                ssq += __shfl_xor(ssq, 16); ssq += __shfl_xor(ssq, 32);
                if (fq == 0) SSQ[vh * 64 + 16 * wI + fr] = ssq;
                __syncthreads();
                const float rstd = 1.0f / sqrtf((SSQ[16 * wI + fr] + SSQ[64 + 16 * wI + fr]) * (1.0f / 128.0f) + 1e-6f);
#pragma unroll
                for (int vt = 0; vt < 4; ++vt) {
                    const int v = 64 * vh + 16 * vt + 4 * fq;
                    const float g0 = siluf_(bflo(graw[vt].x)), g1 = siluf_(bfhi(graw[vt].x)), g2 = siluf_(bflo(graw[vt].y)), g3 = siluf_(bfhi(graw[vt].y));
                    u32x2 w; w.x = pk2(o[vt][0] * rstd * gnv[vt][0] * g0, o[vt][1] * rstd * gnv[vt][1] * g1); w.y = pk2(o[vt][2] * rstd * gnv[vt][2] * g2, o[vt][3] * rstd * gnv[vt][3] * g3);
                    *(u32x2*)(XN + orow * DM + 1024 + h * 128 + v) = w;
                }
            }
            __syncthreads();
        }
        int lane4; asm volatile("v_mbcnt_lo_u32_b32 %0, -1, 0\n\tv_mbcnt_hi_u32_b32 %0, -1, %0" : "=v"(lane4));
        const int gt4 = bid * 512 + wave * 64 + lane4;
        for (int gid = gt4; gid < 131072; gid += NGT) {
            const int ch = gid & 1023, cidx = gid >> 10, chunk = cidx & 63, b = cidx >> 6;
            float hst = 0.f;
#pragma unroll 1
            for (int cc0 = 0; cc0 < chunk; cc0 += 8) {
                f32x2 ag[8];
#pragma unroll
                for (int u = 0; u < 8; ++u) { const int cc = (cc0 + u < 63) ? cc0 + u : 63; ag[u] = AGG[(b * 64 + cc) * 1024 + ch]; }
#pragma unroll
                for (int u = 0; u < 8; ++u) if (cc0 + u < chunk) hst = ag[u].x * hst + ag[u].y;
            }
            const unsigned* src = LAU + (size_t)cidx * 128 * 1024 + ch;
            const size_t trow = (size_t)cidx * 128;
#pragma unroll 1
            for (int t0 = 0; t0 < 128; t0 += 16) {
                unsigned w[16]; bf16_t yv[16];
#pragma unroll
                for (int u = 0; u < 16; ++u) { w[u] = src[(size_t)(t0 + u) * 1024]; yv[u] = BIG[(trow + t0 + u) * INC + 1024 + ch]; }
#pragma unroll
                for (int u = 0; u < 16; ++u) {
                    hst = __expf(bflo(w[u])) * hst + bfhi(w[u]);
                    XN[(trow + t0 + u) * DM + ch] = (bf16_t)(pk2(hst * gelu_tanh(bf2f(yv[u])), 0.f) & 0xffffu);
                }
            }
        }
        transpose_job(p.w_qkv, DM, INC, WA, -1, p.norm_mix + DM, lds, gw, NGW, wave, lane4);
        for (int idx = gt4; idx < NTOK * 16; idx += NGT) {
            const int row = idx >> 4, i = idx & 15;
            const float invf = exp2f(-(float)i * (18.931568569324174f / 16.0f));
            const float ang = (float)p.pos[row] * invf;
            const double rev = (double)ang * 0.15915494309189535;
            const float fr_ = (float)(rev - __builtin_rint(rev));
            TAB[(size_t)idx * 2] = __builtin_amdgcn_cosf(fr_); TAB[(size_t)idx * 2 + 1] = __builtin_amdgcn_sinf(fr_);
        }
    PHASE_END

    PHASE_BEGIN
        pg8::Gemm g{XN, WB, DM, DM, DM, 0, 0}; pg8::Order S; S.init(NTOK, DM, 1, G, bid);
        pg8::EpiResidB<true> E{p.x, nullptr, HB, SSQP};
        pg8::gemm_phase(lds, g, S, E, tid);
    PHASE_END

    PHASE_BEGIN
        pg8::Gemm g{HB, W1, DM, DM, DM, 0, 0}; pg8::Order S; S.init(NTOK, DFF, 1, G, bid);
        fill_rstd_table(RT, SSQP, S, tid);
        pg8::EpiBf16<1, true> E{BIG, DFF, RT};
        pg8::gemm_phase(lds, g, S, E, tid);
    PHASE_END

    PHASE_BEGIN
        pg8::Gemm g{BIG, W2, DFF, DFF, DFF, 0, 0}; pg8::Order S; S.init(NTOK, DM, 1, G, bid);
        pg8::EpiResidB<false> E{nullptr, HB, HB, SSQP};
        pg8::gemm_phase(lds, g, S, E, tid);
    PHASE_END

    PHASE_BEGIN
        pg8::Gemm g{HB, WA, DM, DM, DM, 0, 0}; pg8::Order S; S.init(NTOK, INC, 1, G, bid);
        fill_rstd_table(RT, SSQP, S, tid);
        pg8::EpiQkv E{BIG, TAB, RT};
        pg8::gemm_phase(lds, g, S, E, tid);
    PHASE_END

    PHASE_BEGIN
        LAS unsigned char* KS = lds + wave * (2 * 32 * HP * 2); LAS unsigned char* VS = KS + 32 * HP * 2;
        for (int it = 0; it * G < 1024; ++it) {
            const int item = (G == 256) ? ((bid & 7) * 128 + it * 32 + (bid >> 3)) : (bid + it * G);
            if (item >= 1024) break;
            const int b = item >> 9, h = (item >> 5) & 15, n = item & 31;
            const int r0 = wave, r1 = wave + 8;
            QTile t0, t1;
            const int fr_ = lane & 15;
            {
                const int pc0 = 32 * wave + fr_, pc1 = pc0 + 16;
                attn_tile_init(t0, BIG, b, h, n, 0, lane); attn_tile_init(t1, BIG, b, h, n, 0, lane);
                attn_q_load(t0, BIG, (size_t)b * SEQ + 256 * n + pc0, h, lane); attn_q_load(t1, BIG, (size_t)b * SEQ + 256 * n + pc1, h, lane);
                int g = 0;
                while (g < 12 && 256 * n - 128 + 32 * g + 31 < 0) ++g;
                const int kidx = tid >> 4, ch = tid & 15;
                u32x4 rk, rv;
                { int mk = 256 * n - 128 + 32 * g + kidx; mk = mk < 0 ? 0 : mk; const size_t row = (size_t)b * SEQ + mk;
                  rk = *(const u32x4*)(BIG + row * INC + 2048 + h * 128 + 8 * ch); rv = *(const u32x4*)(BIG + row * INC + 4096 + h * 128 + 8 * ch); }
                __syncthreads();
                int buf = 0;
#pragma unroll 1
                for (; g < 12; ++g) {
                    const int mk0 = 256 * n - 128 + 32 * g;
                    LAS unsigned char* SK = lds + buf * 17408; LAS unsigned char* SV = SK + 8704;
                    *(LAS u32x4*)(SK + (kidx * HP + 8 * ch) * 2) = rk; *(LAS u32x4*)(SV + (kidx * HP + 8 * ch) * 2) = rv;
                    __syncthreads();
                    if (g + 1 < 12) { const size_t row = (size_t)b * SEQ + (mk0 + 32 + kidx);
                        rk = *(const u32x4*)(BIG + row * INC + 2048 + h * 128 + 8 * ch); rv = *(const u32x4*)(BIG + row * INC + 4096 + h * 128 + 8 * ch); }
                    if (g >= wave && g <= wave + 4) attn_pair_update(t0, 256 * n + pc0, t1, 256 * n + pc1, mk0, lds_addr_of(SV), SK, lane);
                    buf ^= 1;
                }
                __syncthreads();
                attn_dump(t0, lds, pc0, lane); attn_dump(t1, lds, pc1, lane);
                __syncthreads();
                attn_pick(t0, lds, 16 * fr_ + r0, lane); attn_pick(t1, lds, 16 * fr_ + r1, lane);
                attn_q_load(t0, BIG, (size_t)b * SEQ + 256 * n + 16 * fr_ + r0, h, lane); attn_q_load(t1, BIG, (size_t)b * SEQ + 256 * n + 16 * fr_ + r1, h, lane);
                __syncthreads();
            }
            attn_branch<true, true>(BIG, b, h, n, 2, wave & 3, 64 * n - 128, 6, t0, r0, t1, r1, KS, VS, lane);
            attn_branch<true, false>(BIG, b, h, n, 4, r0, 16 * n - 144, 5, t0, r0, t1, r1, KS, VS, lane);
            attn_branch<false, true>(BIG, b, h, n, 4, r1, 16 * n - 144, 5, t0, r0, t1, r1, KS, VS, lane);
            attn_tile_store(t0, XN, b, h, n, r0, lane); attn_tile_store(t1, XN, b, h, n, r1, lane);
        }
        __syncthreads();
        int lane3; asm volatile("v_mbcnt_lo_u32_b32 %0, -1, 0\n\tv_mbcnt_hi_u32_b32 %0, -1, %0" : "=v"(lane3));
        transpose_job(p.w_o, DM, DM, WB, -1, nullptr, lds, gw, NGW, wave, lane3);
        transpose_job(p.w1 + (size_t)DM * DFF, DM, DFF, W1, -1, p.norm_mlp + DM, lds, gw, NGW, wave, lane3);
        transpose_job(p.w2 + (size_t)DM * DFF, DFF, DM, W2, -1, nullptr, lds, gw, NGW, wave, lane3);
    PHASE_END

    PHASE_BEGIN
        pg8::Gemm g{XN, WB, DM, DM, DM, 0, 0}; pg8::Order S; S.init(NTOK, DM, 1, G, bid);
        pg8::EpiResidB<false> E{nullptr, HB, HB, SSQP};
        pg8::gemm_phase(lds, g, S, E, tid);
    PHASE_END

    PHASE_BEGIN
        pg8::Gemm g{HB, W1, DM, DM, DM, 0, 0}; pg8::Order S; S.init(NTOK, DFF, 1, G, bid);
        fill_rstd_table(RT, SSQP, S, tid);
        pg8::EpiBf16<1, true> E{BIG, DFF, RT};
        pg8::gemm_phase(lds, g, S, E, tid);
    PHASE_END

    PHASE_BEGIN
        pg8::Gemm g{BIG, W2, DFF, DFF, DFF, 0, 0}; pg8::Order S; S.init(NTOK, DM, 1, G, bid);
        pg8::EpiResidB<false> E{nullptr, HB, HB, nullptr};
        pg8::gemm_phase(lds, g, S, E, tid);
    PHASE_END

    PHASE_BEGIN
        norm_rows_from_bf16<true>(HB, p.final_norm, nullptr, p.out, gw, NGW, lane);
    PHASE_END
#undef PHASE_BEGIN
#undef PHASE_END
}
constexpr int N_PHASES = 14;

extern "C" void kernel_launch(void* const* d_in, const int* in_sizes, int n_in, void* d_out, int out_size, void* d_ws, size_t ws_size, hipStream_t stream) {
    static int grid = 0;
    if (grid == 0) {
        if (n_in != 20 || ws_size < WS_END) { fprintf(stderr, "kernel_launch: unexpected n_in %d / ws_size %zu\n", n_in, ws_size); grid = -1; return; }
        int dev = 0, cus = 0, per_cu = 0;
        hipGetDevice(&dev);
        hipDeviceGetAttribute(&cus, hipDeviceAttributeMultiprocessorCount, dev);
        if (hipFuncSetAttribute((const void*)mega, hipFuncAttributeMaxDynamicSharedMemorySize, LDS_BYTES) != hipSuccess) { fprintf(stderr, "kernel_launch: hipFuncSetAttribute failed\n"); grid = -1; return; }
        if (hipOccupancyMaxActiveBlocksPerMultiprocessor(&per_cu, (const void*)mega, 512, LDS_BYTES) != hipSuccess || per_cu < 1) { fprintf(stderr, "kernel_launch: occupancy query says %d\n", per_cu); per_cu = 1; }
        (void)hipGetLastError();
        grid = cus * 1;
    }
    if (grid < 0) return;
    Params p{};
    p.x = (const float*)d_in[0]; p.pos = (const int*)d_in[1]; p.norm_mix = (const float*)d_in[2]; p.norm_mlp = (const float*)d_in[3]; p.final_norm = (const float*)d_in[4];
    p.w_in = (const float*)d_in[5]; p.conv_w = (const float*)d_in[6]; p.conv_b = (const float*)d_in[7]; p.w_a = (const float*)d_in[8]; p.b_a = (const float*)d_in[9];
    p.w_i = (const float*)d_in[10]; p.b_i = (const float*)d_in[11]; p.lam = (const float*)d_in[12]; p.lb_logits = (const float*)d_in[13]; p.g_norm = (const float*)d_in[14];
    p.w_out = (const float*)d_in[15]; p.w_qkv = (const float*)d_in[16]; p.w_o = (const float*)d_in[17]; p.w1 = (const float*)d_in[18]; p.w2 = (const float*)d_in[19];
    p.out = (float*)d_out; p.ws = (unsigned char*)d_ws;
    if (hipMemsetAsync((unsigned char*)d_ws + WS_CTR, 0, 256, stream) != hipSuccess) { fprintf(stderr, "kernel_launch: memset of the barrier word failed\n"); return; }
    int lo = 0, hi = N_PHASES;
    void* args[] = {&p, &lo, &hi};
    hipError_t e = hipLaunchCooperativeKernel((const void*)mega, dim3(grid), dim3(512), args, LDS_BYTES, stream);
    if (e != hipSuccess) fprintf(stderr, "kernel_launch: cooperative launch failed: %s (grid %d)\n", hipGetErrorString(e), grid);
}
```
